# Optimizing an MI355X kernel written in HIP

```python
import jax
import jax.numpy as jnp
from jax import lax
import numpy as np

D_MODEL = 2048
BATCH = 8
SEQ = 4096
DEPTH = 1

M_HEADS = 4
M_QK = 128
M_V = 256
CONV_W = 4
G_HEADS = 4
G_K = 128
G_V = 256
G_RANK = 16
G_TAU = 16.0
CHUNK = 64
N_EXPERTS = 32
TOP_K = 4
D_FF = D_MODEL
SWIGLU_ALPHA = 1.702
SWIGLU_LIMIT = 7.0
MOE_BLOCK = 256
NORM_EPS = 1e-5
DN_ALPHA = (2 * DEPTH) ** 0.25
DN_BETA = (8 * DEPTH) ** -0.25

M_QKW = M_HEADS * M_QK
M_VW = M_HEADS * M_V
G_KW = G_HEADS * G_K
G_VW = G_HEADS * G_V
SPLIT_SIZES = (M_QKW, M_QKW, M_VW, M_VW, M_HEADS, M_HEADS, G_KW, G_KW, G_VW, G_VW, G_RANK, D_MODEL, D_MODEL)
D_IN = sum(SPLIT_SIZES)
F_GATE_COL = sum(SPLIT_SIZES[:5])

kernel_name = 'hybrid_mlstm_gla_moe_deepnorm'


def _layer_norm(x, g, b):
    xf = x.astype(jnp.float32)
    mu = jnp.mean(xf, axis=-1, keepdims=True)
    var = jnp.mean(jnp.square(xf - mu), axis=-1, keepdims=True)
    return ((xf - mu) * lax.rsqrt(var + NORM_EPS)).astype(x.dtype) * g + b


def _head_layer_norm(h, w, dtype):
    B, S = h.shape[:2]
    mu = jnp.mean(h, axis=-1, keepdims=True)
    var = jnp.mean(jnp.square(h - mu), axis=-1, keepdims=True)
    return ((h - mu) * lax.rsqrt(var + NORM_EPS)).reshape(B, S, -1).astype(dtype) * w


def _head_rms_norm(h, w, dtype):
    B, S = h.shape[:2]
    ms = jnp.mean(jnp.square(h), axis=-1, keepdims=True)
    return (h * lax.rsqrt(ms + NORM_EPS)).reshape(B, S, -1).astype(dtype) * w


def _causal_dwconv(u, w, b):
    C = u.shape[-1]
    y = lax.conv_general_dilated(u, w[:, None, :].astype(u.dtype), window_strides=(1,),
                                 padding=[(CONV_W - 1, 0)], dimension_numbers=('NWC', 'WIO', 'NWC'),
                                 feature_group_count=C)
    return y + b


def _to_chunks(t):
    B, S = t.shape[:2]
    t = t.reshape((B, S // CHUNK, CHUNK) + t.shape[2:])
    return jnp.moveaxis(t, 3, 1)


def _from_chunks(t):
    B, H, NC, L, d = t.shape
    return jnp.moveaxis(t, 1, 3).reshape(B, NC * L, H, d)


def _mlstm(q, k, v, i_pre, f_pre):
    B, S, H, DK = q.shape
    DV = v.shape[-1]
    f32 = jnp.float32
    q = _to_chunks(q).astype(f32)
    k = _to_chunks(k).astype(f32) * DK ** -0.5
    v = _to_chunks(v).astype(f32)
    log_i = _to_chunks(i_pre).astype(f32)
    log_f = jax.nn.log_sigmoid(_to_chunks(f_pre).astype(f32))
    b = jnp.cumsum(log_f, axis=-1)
    b_end = b[..., -1]
    causal = jnp.tril(jnp.ones((CHUNK, CHUNK), dtype=bool))
    d_log = jnp.where(causal, b[..., :, None] - b[..., None, :] + log_i[..., None, :], -jnp.inf)
    w_end = b_end[..., None] - b + log_i
    g_end = jnp.max(w_end, axis=-1)
    ke = k * jnp.exp(w_end - g_end[..., None])[..., None]
    dC = jnp.einsum('bhcsd,bhcse->bhcde', ke, v)
    dn = jnp.sum(ke, axis=-2)

    def step(carry, xs):
        C, n, m = carry
        dC_c, dn_c, g_c, be_c = xs
        m_new = jnp.maximum(be_c + m, g_c)
        a = jnp.exp(be_c + m - m_new)
        c = jnp.exp(g_c - m_new)
        C_new = a[..., None, None] * C + c[..., None, None] * dC_c
        n_new = a[..., None] * n + c[..., None] * dn_c
        return (C_new, n_new, m_new), (C, n, m)

    init = (jnp.zeros((B, H, DK, DV), f32), jnp.zeros((B, H, DK), f32), jnp.zeros((B, H), f32))
    xs = (jnp.moveaxis(dC, 2, 0), jnp.moveaxis(dn, 2, 0), jnp.moveaxis(g_end, 2, 0), jnp.moveaxis(b_end, 2, 0))
    _, (C_prev, n_prev, m_prev) = lax.scan(step, init, xs)
    C_prev = jnp.moveaxis(C_prev, 0, 2)
    n_prev = jnp.moveaxis(n_prev, 0, 2)
    m_prev = jnp.moveaxis(m_prev, 0, 2)
    m_inter = b + m_prev[..., None]
    m_t = jnp.maximum(m_inter, jnp.max(d_log, axis=-1))
    dec = jnp.exp(m_inter - m_t)
    s = jnp.einsum('bhcld,bhcsd->bhcls', q, k) * jnp.exp(d_log - m_t[..., None])
    num = jnp.einsum('bhcls,bhcse->bhcle', s, v) + dec[..., None] * jnp.einsum('bhcld,bhcde->bhcle', q, C_prev)
    den = jnp.sum(s, axis=-1) + dec * jnp.einsum('bhcld,bhcd->bhcl', q, n_prev)
    h = num / jnp.maximum(jnp.abs(den), jnp.exp(-m_t))[..., None]
    return _from_chunks(h)


def _gla(q, k, v, log_a):
    B, S, H, DK = q.shape
    DV = v.shape[-1]
    f32 = jnp.float32
    q = _to_chunks(q).astype(f32) * DK ** -0.5
    k = _to_chunks(k).astype(f32)
    v = _to_chunks(v).astype(f32)
    cum = jnp.cumsum(_to_chunks(log_a).astype(f32), axis=3)
    cum_end = cum[..., -1, :]
    q_in = q * jnp.exp(cum)
    k_in = k * jnp.exp(-cum)
    k_end = k * jnp.exp(cum_end[..., None, :] - cum)
    dS = jnp.einsum('bhcsd,bhcse->bhcde', k_end, v)

    def step(S_c, xs):
        dec_c, dS_c = xs
        return dec_c[..., None] * S_c + dS_c, S_c

    _, S_prev = lax.scan(step, jnp.zeros((B, H, DK, DV), f32),
                         (jnp.moveaxis(jnp.exp(cum_end), 2, 0), jnp.moveaxis(dS, 2, 0)))
    S_prev = jnp.moveaxis(S_prev, 0, 2)
    causal = jnp.tril(jnp.ones((CHUNK, CHUNK), dtype=bool))
    s = jnp.where(causal, jnp.einsum('bhcld,bhcsd->bhcls', q_in, k_in), 0.0)
    o = jnp.einsum('bhcls,bhcse->bhcle', s, v) + jnp.einsum('bhcld,bhcde->bhcle', q_in, S_prev)
    return _from_chunks(o)


def _token_mix(u, w_in, b_in, conv_w, conv_b, w_gla_gate, b_gla_gate, m_norm_w, g_norm_w,
               w_branch_m, w_branch_g, w_out):
    B, S, _ = u.shape
    proj = u @ w_in + b_in
    split_idx = [int(c) for c in np.cumsum(SPLIT_SIZES)[:-1]]
    mq, mk, mv, mo, mi, mf, gq, gk, gv, gg, glr, gate_m, gate_g = jnp.split(proj, split_idx, axis=-1)
    qk = jax.nn.silu(_causal_dwconv(jnp.concatenate([mq, mk], axis=-1), conv_w, conv_b))
    q_m = qk[..., :M_QKW].reshape(B, S, M_HEADS, M_QK)
    k_m = qk[..., M_QKW:].reshape(B, S, M_HEADS, M_QK)
    h_m = _mlstm(q_m, k_m, mv.reshape(B, S, M_HEADS, M_V), mi, mf)
    y_m = _head_layer_norm(h_m, m_norm_w, u.dtype) * jax.nn.sigmoid(mo)
    log_a = jax.nn.log_sigmoid((glr @ w_gla_gate + b_gla_gate).astype(jnp.float32)) / G_TAU
    o_g = _gla(gq.reshape(B, S, G_HEADS, G_K), gk.reshape(B, S, G_HEADS, G_K),
               gv.reshape(B, S, G_HEADS, G_V), log_a.reshape(B, S, G_HEADS, G_K))
    y_g = _head_rms_norm(o_g, g_norm_w, u.dtype) * jax.nn.silu(gg)
    z = jax.nn.sigmoid(gate_m) * (y_m @ w_branch_m) + jax.nn.sigmoid(gate_g) * (y_g @ w_branch_g)
    return z @ w_out


def _moe(h, w_router, b_router, w_gu, b_gu, w_down, b_down):
    B, S, D = h.shape
    T = B * S
    A = T * TOP_K
    hf = h.reshape(T, D)
    logits = (hf @ w_router + b_router).astype(jnp.float32)
    top_v, top_e = lax.top_k(logits, TOP_K)
    gates = jax.nn.softmax(top_v, axis=-1).astype(h.dtype)
    e_flat = top_e.reshape(A).astype(jnp.int32)
    tok_flat = jnp.arange(A, dtype=jnp.int32) // TOP_K
    g_flat = gates.reshape(A)
    order = jnp.argsort(e_flat)
    e_sorted = e_flat[order]
    counts = jnp.zeros((N_EXPERTS,), jnp.int32).at[e_flat].add(1)
    padded = (counts + MOE_BLOCK - 1) // MOE_BLOCK * MOE_BLOCK
    start = jnp.cumsum(counts) - counts
    pend = jnp.cumsum(padded)
    pstart = pend - padded
    dest = pstart[e_sorted] + (jnp.arange(A, dtype=jnp.int32) - start[e_sorted])
    n_blocks = -(-A // MOE_BLOCK) + N_EXPERTS
    P = n_blocks * MOE_BLOCK
    buf_tok = jnp.full((P,), T, jnp.int32).at[dest].set(tok_flat[order])
    buf_gate = jnp.zeros((P,), h.dtype).at[dest].set(g_flat[order])
    block_e = jnp.searchsorted(pend, jnp.arange(n_blocks, dtype=jnp.int32) * MOE_BLOCK, side='right')
    block_e = jnp.minimum(block_e, N_EXPERTS - 1).astype(jnp.int32)
    h_pad = jnp.concatenate([hf, jnp.zeros((1, D), hf.dtype)], axis=0)

    def run_block(args):
        tok, gate, e = args
        xb = h_pad[tok]
        gu = xb @ w_gu[e] + b_gu[e]
        a_glu = jnp.minimum(gu[:, :D_FF], SWIGLU_LIMIT)
        a_lin = jnp.clip(gu[:, D_FF:], -SWIGLU_LIMIT, SWIGLU_LIMIT)
        act = a_glu * jax.nn.sigmoid(SWIGLU_ALPHA * a_glu) * (a_lin + 1.0)
        return (act @ w_down[e] + b_down[e]) * gate[:, None]

    out = lax.map(run_block, (buf_tok.reshape(n_blocks, MOE_BLOCK), buf_gate.reshape(n_blocks, MOE_BLOCK), block_e))
    y = jax.ops.segment_sum(out.reshape(P, D), buf_tok, num_segments=T + 1)[:T]
    return y.reshape(B, S, D)


def setup_inputs(seed: int = 0) -> dict:
    key = jax.random.key(seed)
    ks = jax.random.split(key, 22)
    L = DEPTH
    f32 = jnp.float32

    def nrm(k, shape, scale):
        return jax.random.normal(k, shape, f32) * scale

    f_bias = jnp.linspace(3.0, 6.0, M_HEADS, dtype=f32)
    return {
        'x': nrm(ks[0], (BATCH, SEQ, D_MODEL), 1.0),
        'w_in': nrm(ks[1], (L, D_MODEL, D_IN), D_MODEL ** -0.5),
        'b_in': nrm(ks[2], (L, D_IN), 0.02).at[:, F_GATE_COL:F_GATE_COL + M_HEADS].add(f_bias),
        'conv_w': nrm(ks[3], (L, CONV_W, 2 * M_QKW), CONV_W ** -0.5),
        'conv_b': nrm(ks[4], (L, 2 * M_QKW), 0.02),
        'w_gla_gate': nrm(ks[5], (L, G_RANK, G_KW), G_RANK ** -0.5),
        'b_gla_gate': nrm(ks[6], (L, G_KW), 0.02),
        'm_norm_w': 1.0 + nrm(ks[7], (L, M_VW), 0.02),
        'g_norm_w': 1.0 + nrm(ks[8], (L, G_VW), 0.02),
        'w_branch_m': nrm(ks[9], (L, M_VW, D_MODEL), M_VW ** -0.5),
        'w_branch_g': nrm(ks[10], (L, G_VW, D_MODEL), G_VW ** -0.5),
        'w_out': nrm(ks[11], (L, D_MODEL, D_MODEL), DN_BETA * D_MODEL ** -0.5),
        'ln1_g': 1.0 + nrm(ks[12], (L, D_MODEL), 0.02),
        'ln1_b': nrm(ks[13], (L, D_MODEL), 0.02),
        'w_router': nrm(ks[14], (L, D_MODEL, N_EXPERTS), D_MODEL ** -0.5),
        'b_router': nrm(ks[15], (L, N_EXPERTS), 0.01),
        'w_gu': nrm(ks[16], (L, N_EXPERTS, D_MODEL, 2 * D_FF), D_MODEL ** -0.5),
        'b_gu': nrm(ks[17], (L, N_EXPERTS, 2 * D_FF), 0.02),
        'w_down': nrm(ks[18], (L, N_EXPERTS, D_FF, D_MODEL), DN_BETA * D_FF ** -0.5),
        'b_down': nrm(ks[19], (L, N_EXPERTS, D_MODEL), 0.02),
        'ln2_g': 1.0 + nrm(ks[20], (L, D_MODEL), 0.02),
        'ln2_b': nrm(ks[21], (L, D_MODEL), 0.02),
    }


def reference(x, w_in, b_in, conv_w, conv_b, w_gla_gate, b_gla_gate, m_norm_w, g_norm_w,
              w_branch_m, w_branch_g, w_out, ln1_g, ln1_b, w_router, b_router, w_gu, b_gu,
              w_down, b_down, ln2_g, ln2_b):
    for l in range(DEPTH):
        mix = _token_mix(x, w_in[l], b_in[l], conv_w[l], conv_b[l], w_gla_gate[l], b_gla_gate[l],
                         m_norm_w[l], g_norm_w[l], w_branch_m[l], w_branch_g[l], w_out[l])
        x = _layer_norm(DN_ALPHA * x + mix, ln1_g[l], ln1_b[l])
        ff = _moe(x, w_router[l], b_router[l], w_gu[l], b_gu[l], w_down[l], b_down[l])
        x = _layer_norm(DN_ALPHA * x + ff, ln2_g[l], ln2_b[l])
    return x
```

```cpp
#include <hip/hip_runtime.h>
#include <cstdio>
#include <cstdint>
#include <cmath>
namespace pg8 {
#define PG8_LAS __attribute__((address_space(3)))
typedef unsigned short bf16_t;
typedef short bf16x8 __attribute__((ext_vector_type(8)));
typedef float f32x4 __attribute__((ext_vector_type(4)));
typedef unsigned u32x4 __attribute__((ext_vector_type(4)));
constexpr int BM = 256, BK = 64, HALF = 128, HTB = HALF * BK * 2  , STAGE_BYTES = 8 * HTB, NXCD = 8, WGM = 8;

__host__ __device__ __forceinline__ int lds_byte(int r, int c) { const int st = (r >> 4) * 2 + (c >> 5), rr = r & 15, cc = c & 31, ob = rr * 64 + cc * 2; return st * 1024 + (ob ^ (((ob >> 9) & 1) << 5)); }
__host__ __device__ __forceinline__ void stage_rc(int b, int& R, int& C) { const int st = b / 1024, sb = b % 1024, swz = sb ^ (((sb >> 9) & 1) << 5); R = (st >> 1) * 16 + swz / 64; C = (st & 1) * 32 + (swz % 64) / 2; }
__host__ __device__ __forceinline__ int perm32(int rho) { const int n = rho >> 4, i = rho & 15; return 8 * (i >> 2) + 4 * n + (i & 3); }

struct Unit { int pm, pn; };
struct Gemm { const bf16_t* A; const bf16_t* Bt; int M, N, K; };

struct StaticOrder {
    int nM, nN, nwg, G, c;
    __host__ __device__ void init(int M, int N, int G_, int c_) { nM = M / BM; nN = N / BM; nwg = nM * nN; G = G_; c = c_; }
    __host__ __device__ bool next(int i, Unit& u) const {
        const long L = (long)i * G + c; if (L >= nwg) return false;
        int wgid = (int)L; { const int q = nwg / NXCD, r = nwg % NXCD, xcd = wgid % NXCD, off = wgid / NXCD; wgid = (xcd < r ? xcd * (q + 1) : r * (q + 1) + (xcd - r) * q) + off; }
        const int nig = WGM * nN, gid = wgid / nig, fm = gid * WGM, gsz = (nM - fm) < WGM ? (nM - fm) : WGM;
        u.pm = fm + ((wgid % nig) % gsz); u.pn = (wgid % nig) / gsz; return true;
    }
    __device__ __forceinline__ void a_ready(const Unit&) const {}
    __device__ __forceinline__ void done(const Unit&) const {}
};

__device__ __forceinline__ unsigned cvt_pk_bf16(float lo, float hi) { unsigned r; asm volatile("v_cvt_pk_bf16_f32 %0, %1, %2" : "=v"(r) : "v"(lo), "v"(hi)); return r; }
typedef float f32x2 __attribute__((ext_vector_type(2)));
template <class Epi, class Sched, bool ALIGN_EPI = false, bool SP2 = false>
__device__ __forceinline__ void gemm_phase(PG8_LAS unsigned char* lds, const Gemm g, const Sched& S, const Epi& E) {
    const int tid = threadIdx.x, wid = __builtin_amdgcn_readfirstlane(tid >> 6), lane = tid & 63, wr = wid >> 2, wc = wid & 3, fr = lane & 15, fq = lane >> 4;
    const int K = g.K, nt = K / BK;
    unsigned voffA[2], voffB[2];
#pragma unroll
    for (int i = 0; i < 2; ++i) { int R, C; stage_rc(tid * 16 + i * 8192, R, C); const int Rb = Epi::PERM ? ((R & ~31) + perm32(R & 31)) : R;
        voffA[i] = (unsigned)(R * K + C) * 2u; voffB[i] = (unsigned)(Rb * K + C) * 2u; }
    const size_t kstep = (size_t)(BK * 2);
    const size_t hstep = (size_t)HALF * K * 2;
    const size_t tstep = 2 * hstep;
    const unsigned ldsw = (unsigned)wid * 1024u;
    const int aoff = lds_byte(wr * 64 + fr, fq * 8), boff = lds_byte(wc * 32 + fr, fq * 8);
#define PG8_SA(b, h) (((b) * 2 + (h)) * HTB)
#define PG8_SB(b, h) ((4 + (b) * 2 + (h)) * HTB)
#define PG8_STAGE(bufoff, gbase, voff) do { _Pragma("unroll") for (int _i = 0; _i < 2; ++_i) \
        __builtin_amdgcn_global_load_lds((const unsigned*)((const char*)(gbase) + (voff)[_i]), (PG8_LAS unsigned*)(lds + (bufoff) + ldsw + _i * 8192), 16, 0, 0); } while (0)
#define PG8_LDA(dst, b, h) do { _Pragma("unroll") for (int m = 0; m < 4; ++m) _Pragma("unroll") for (int k = 0; k < 2; ++k) dst[m][k] = *(const PG8_LAS bf16x8*)(lds + PG8_SA(b, h) + aoff + m * 2048 + k * 1024); } while (0)
#define PG8_LDB(dst, b, h) do { _Pragma("unroll") for (int n = 0; n < 2; ++n) _Pragma("unroll") for (int k = 0; k < 2; ++k) dst[n][k] = *(const PG8_LAS bf16x8*)(lds + PG8_SB(b, h) + boff + n * 2048 + k * 1024); } while (0)
#define PG8_MMA(ai, bj, At, Bt) do { __builtin_amdgcn_s_setprio(1); _Pragma("unroll") for (int m = 0; m < 4; ++m) _Pragma("unroll") for (int n = 0; n < 2; ++n) _Pragma("unroll") for (int k = 0; k < 2; ++k) \
        acc[ai][bj][m][n] = __builtin_amdgcn_mfma_f32_16x16x32_bf16(Bt[n][k], At[m][k], acc[ai][bj][m][n], 0, 0, 0); __builtin_amdgcn_s_setprio(0); } while (0)
#define PG8_WAIT_V(n) asm volatile("s_waitcnt vmcnt(" #n ")" ::: "memory")
#define PG8_WAIT_L(n) asm volatile("s_waitcnt lgkmcnt(" #n ")" ::: "memory")
#define PG8_BAR __builtin_amdgcn_s_barrier()
#define PG8_SCHED __builtin_amdgcn_sched_barrier(0)
    Unit cur, nxt; int ui = 0;
    if (!S.next(0, cur)) return;
    f32x4 acc[2][2][4][2];
#pragma unroll
    for (int a = 0; a < 2; ++a)
#pragma unroll
        for (int b = 0; b < 2; ++b)
#pragma unroll
            for (int m = 0; m < 4; ++m)
#pragma unroll
                for (int n = 0; n < 2; ++n) acc[a][b][m][n] = (f32x4){0.f, 0.f, 0.f, 0.f};
    bf16x8 At[4][2], B0[2][2], B1[2][2];
    const char* cA = (const char*)g.A + (size_t)cur.pm * tstep; const char* cB = (const char*)g.Bt + (size_t)cur.pn * tstep;
    S.a_ready(cur);
    if constexpr (SP2) {
        PG8_STAGE(PG8_SB(0, 0), cB, voffB); PG8_STAGE(PG8_SB(0, 1), cB + hstep, voffB); PG8_STAGE(PG8_SA(0, 0), cA, voffA); PG8_STAGE(PG8_SA(0, 1), cA + hstep, voffA);
        if (wr == 1) PG8_BAR;
        PG8_WAIT_V(2); PG8_BAR;
        PG8_STAGE(PG8_SB(1, 0), cB + kstep, voffB); PG8_STAGE(PG8_SA(1, 0), cA + kstep, voffA); PG8_STAGE(PG8_SB(1, 1), cB + hstep + kstep, voffB);
        PG8_WAIT_V(6); PG8_BAR;
    } else {
        PG8_STAGE(PG8_SB(0, 0), cB, voffB); PG8_STAGE(PG8_SA(0, 0), cA, voffA); PG8_STAGE(PG8_SB(0, 1), cB + hstep, voffB); PG8_STAGE(PG8_SA(0, 1), cA + hstep, voffA);
        if (wr == 1) PG8_BAR;
        PG8_WAIT_V(4); PG8_BAR;
        PG8_STAGE(PG8_SB(1, 0), cB + kstep, voffB); PG8_STAGE(PG8_SA(1, 0), cA + kstep, voffA); PG8_STAGE(PG8_SB(1, 1), cB + hstep + kstep, voffB);
        PG8_WAIT_V(6); PG8_BAR;
    }
    for (;;) {
        const bool has_next = S.next(ui + 1, nxt);
        const char* nA = has_next ? (const char*)g.A + (size_t)nxt.pm * tstep : cA; const char* nB = has_next ? (const char*)g.Bt + (size_t)nxt.pn * tstep : cB;
        for (int t = 0; t < nt; t += 2) {
            const bool last = (t == nt - 2);
            const char* a1 = cA + (size_t)(t + 1) * kstep;
            const char* a2 = last ? nA : cA + (size_t)(t + 2) * kstep; const char* b2 = last ? nB : cB + (size_t)(t + 2) * kstep;
            const char* a3 = a2 + kstep; const char* b3 = b2 + kstep;
            if (last && has_next) S.a_ready(nxt);
            if constexpr (SP2) {
            PG8_LDB(B0, 0, 0); PG8_LDB(B1, 0, 1); PG8_SCHED; PG8_LDA(At, 0, 0); PG8_STAGE(PG8_SA(1, 1), a1 + hstep, voffA);
            PG8_WAIT_V(8); PG8_WAIT_L(0); PG8_BAR; PG8_MMA(0, 0, At, B0); PG8_MMA(0, 1, At, B1); PG8_BAR; PG8_SCHED;
            PG8_LDA(At, 0, 1); PG8_STAGE(PG8_SB(0, 0), b2, voffB); PG8_STAGE(PG8_SB(0, 1), b2 + hstep, voffB); PG8_STAGE(PG8_SA(0, 0), a2, voffA);
            PG8_WAIT_V(8); PG8_WAIT_L(0); PG8_BAR; PG8_MMA(1, 0, At, B0); PG8_MMA(1, 1, At, B1); PG8_BAR; PG8_SCHED;
            PG8_LDB(B0, 1, 0); PG8_LDB(B1, 1, 1); PG8_SCHED; PG8_LDA(At, 1, 0); PG8_STAGE(PG8_SA(0, 1), a2 + hstep, voffA);
            PG8_WAIT_V(8); PG8_WAIT_L(0); PG8_BAR; PG8_MMA(0, 0, At, B0); PG8_MMA(0, 1, At, B1); PG8_BAR; PG8_SCHED;
            PG8_LDA(At, 1, 1); PG8_STAGE(PG8_SB(1, 0), b3, voffB); PG8_STAGE(PG8_SB(1, 1), b3 + hstep, voffB); PG8_STAGE(PG8_SA(1, 0), a3, voffA);
            PG8_WAIT_V(8); PG8_WAIT_L(0); PG8_BAR; PG8_MMA(1, 0, At, B0); PG8_MMA(1, 1, At, B1); PG8_BAR; PG8_SCHED;
            } else {
            PG8_LDB(B0, 0, 0); PG8_SCHED; PG8_LDA(At, 0, 0); PG8_STAGE(PG8_SA(1, 1), a1 + hstep, voffA);
            PG8_WAIT_L(8); PG8_BAR; PG8_WAIT_L(0); PG8_MMA(0, 0, At, B0); PG8_BAR; PG8_SCHED;
            PG8_LDB(B1, 0, 1); PG8_STAGE(PG8_SB(0, 0), b2, voffB);
            PG8_BAR; PG8_WAIT_L(0); PG8_MMA(0, 1, At, B1); PG8_BAR;
            PG8_LDA(At, 0, 1); PG8_STAGE(PG8_SA(0, 0), a2, voffA);
            PG8_BAR; PG8_WAIT_L(0); PG8_MMA(1, 0, At, B0); PG8_BAR; PG8_SCHED;
            PG8_STAGE(PG8_SB(0, 1), b2 + hstep, voffB);
            PG8_WAIT_V(6); PG8_BAR; PG8_MMA(1, 1, At, B1); PG8_BAR;
            PG8_LDB(B0, 1, 0); PG8_SCHED; PG8_LDA(At, 1, 0); PG8_STAGE(PG8_SA(0, 1), a2 + hstep, voffA);
            PG8_WAIT_L(8); PG8_BAR; PG8_WAIT_L(0); PG8_MMA(0, 0, At, B0); PG8_BAR; PG8_SCHED;
            PG8_LDB(B1, 1, 1); PG8_STAGE(PG8_SB(1, 0), b3, voffB);
            PG8_BAR; PG8_WAIT_L(0); PG8_MMA(0, 1, At, B1); PG8_BAR;
            PG8_LDA(At, 1, 1); PG8_STAGE(PG8_SA(1, 0), a3, voffA);
            PG8_BAR; PG8_WAIT_L(0); PG8_MMA(1, 0, At, B0); PG8_BAR; PG8_SCHED;
            PG8_STAGE(PG8_SB(1, 1), b3 + hstep, voffB);
            PG8_WAIT_V(6); PG8_BAR; PG8_MMA(1, 1, At, B1); PG8_BAR;
            }
        }
        if constexpr (ALIGN_EPI) { if (wr == 0) PG8_BAR; }
        if constexpr (!Epi::AFTER_DRAIN) { E(acc, cur, wr, wc, fr, fq); S.done(cur); }
        if (!has_next) break;
#pragma unroll
        for (int a = 0; a < 2; ++a)
#pragma unroll
            for (int b = 0; b < 2; ++b)
#pragma unroll
                for (int m = 0; m < 4; ++m)
#pragma unroll
                    for (int n = 0; n < 2; ++n) acc[a][b][m][n] = (f32x4){0.f, 0.f, 0.f, 0.f};
        cur = nxt; cA = nA; cB = nB; ++ui;
        if constexpr (ALIGN_EPI) { if (wr == 1) PG8_BAR; }
    }
    PG8_WAIT_V(0);
    if constexpr (!ALIGN_EPI) { if (wr == 0) PG8_BAR; }
    PG8_BAR;
    if constexpr (Epi::AFTER_DRAIN) { E.fused(acc, cur, wr, wc, fr, fq, lds, wid, lane); S.done(cur); }
#undef PG8_SA
#undef PG8_SB
#undef PG8_STAGE
#undef PG8_LDA
#undef PG8_LDB
#undef PG8_MMA
#undef PG8_WAIT_V
#undef PG8_WAIT_L
#undef PG8_BAR
#undef PG8_SCHED
}
}
#define GAS __attribute__((address_space(1)))
#define LAS __attribute__((address_space(3)))
typedef unsigned short bf16;
typedef unsigned v4u __attribute__((ext_vector_type(4)));
typedef float f32x4 __attribute__((ext_vector_type(4)));
typedef short bf16x8 __attribute__((ext_vector_type(8)));
typedef GAS unsigned gu32;
typedef GAS unsigned long long gu64;
#define RLX_AGENT __ATOMIC_RELAXED, __HIP_MEMORY_SCOPE_AGENT
#define LDS_WAIT() asm volatile("s_waitcnt lgkmcnt(0)" ::: "memory")
#define VM_WAIT() asm volatile("s_waitcnt vmcnt(0)" ::: "memory")
__device__ __forceinline__ unsigned long long rt() { return __builtin_amdgcn_s_memrealtime(); }
__device__ __forceinline__ unsigned f2bf(float f) { unsigned u = __builtin_bit_cast(unsigned, f); return (u + 0x7fffu + ((u >> 16) & 1u)) >> 16; }
__device__ __forceinline__ unsigned pk2(float lo, float hi) { return f2bf(lo) | (f2bf(hi) << 16); }

#define XB_TMO      128
#define XB_XCNT(j)  (256  + 64 * (j))
#define XB_XSUB(j)  (1280 + 64 * (j))
#define XB_XGEN(j)  (2304 + 64 * (j))
#define XB_TOP      3328
#define XB_TOPGEN   3392
#define XCD_BAR_WORDS 3456
#define XB_SPIN_CAP (1u << 18)

__device__ __forceinline__ unsigned xb_ld(unsigned* p)              { return __hip_atomic_load(p, __ATOMIC_RELAXED, __HIP_MEMORY_SCOPE_AGENT); }
__device__ __forceinline__ unsigned xb_add(unsigned* p, unsigned v) { return __hip_atomic_fetch_add(p, v, __ATOMIC_RELAXED, __HIP_MEMORY_SCOPE_AGENT); }
__device__ __forceinline__ unsigned xb_xcc_id() { return (unsigned)__builtin_amdgcn_s_getreg((3 << 11) | 20) & 0xFu; }
#define XB_SPIN(cond, bar) do { unsigned _sp = 0; while (cond) { __builtin_amdgcn_s_sleep(1); \
    if ((++_sp & 255u) == 0u) { if (xb_ld(&(bar)[XB_TMO])) break; if (_sp > XB_SPIN_CAP) { atomicAdd(&(bar)[XB_TMO], 1u); break; } } } } while (0)

struct XcdBarrier {
    unsigned* bar; unsigned x;
    volatile LAS unsigned* st;
};

__device__ __forceinline__ XcdBarrier xcd_barrier_post(unsigned* bar, volatile LAS unsigned* st) {
    XcdBarrier b; b.bar = bar; b.x = xb_xcc_id(); b.st = st;
    if (threadIdx.x == 0) (void)xb_add(&bar[XB_XCNT(b.x)], 1u);
    return b;
}
__device__ __forceinline__ void xcd_barrier_complete(unsigned* bar, unsigned x, unsigned& nloc, unsigned& nx) {
    const unsigned G = gridDim.x * gridDim.y * gridDim.z;
    unsigned sum, cnt, mine, sp = 0u;
    for (;;) {
        sum = 0u; cnt = 0u; mine = 0u;
#pragma unroll
        for (unsigned j = 0; j < 16; ++j) { const unsigned c = xb_ld(&bar[XB_XCNT(j)]); sum += c; cnt += (c > 0u) ? 1u : 0u; mine = (j == x) ? c : mine; }
        if (sum == G) break;
        __builtin_amdgcn_s_sleep(1);
        if ((++sp & 255u) == 0u) { if (xb_ld(&bar[XB_TMO])) break; if (sp > XB_SPIN_CAP) { atomicAdd(&bar[XB_TMO], 1u); break; } }
    }
    nloc = mine > 0u ? mine : 1u; nx = cnt > 0u ? cnt : 1u;
}

__device__ __forceinline__ void xcd_barrier(const XcdBarrier& b) {
    asm volatile("s_waitcnt vmcnt(0)" ::: "memory");
    __syncthreads();
    if (threadIdx.x == 0) {
        unsigned* bar = b.bar;
        __builtin_amdgcn_s_waitcnt(0);
        unsigned nloc = b.st[0], nx = b.st[1];
        if (nloc == 0u) { xcd_barrier_complete(bar, b.x, nloc, nx); b.st[0] = nloc; b.st[1] = nx; }
        const unsigned old = xb_add(&bar[XB_XSUB(b.x)], 1u);
        const unsigned gen = old / nloc;
        if (old + 1u == (gen + 1u) * nloc) {
            __builtin_amdgcn_fence(__ATOMIC_RELEASE, "agent");
            asm volatile("s_waitcnt vmcnt(0)" ::: "memory");
            const unsigned og = xb_add(&bar[XB_TOP], 1u);
            const unsigned tg = og / nx;
            if (og + 1u == (tg + 1u) * nx) xb_add(&bar[XB_TOPGEN], 1u);
            else XB_SPIN(xb_ld(&bar[XB_TOPGEN]) == tg, bar);
            __builtin_amdgcn_fence(__ATOMIC_ACQUIRE, "agent");
            xb_add(&bar[XB_XGEN(b.x)], 1u);
            asm volatile("s_waitcnt vmcnt(0)" ::: "memory");
        } else {
            XB_SPIN(xb_ld(&bar[XB_XGEN(b.x)]) == gen, bar);
            __builtin_amdgcn_fence(__ATOMIC_ACQUIRE, "agent");
            asm volatile("s_waitcnt vmcnt(0)" ::: "memory");
        }
    }
    __syncthreads();
}

constexpr int NWAVES = 8, NTHR = NWAVES * 64;
constexpr int BATCH = 8, SEQ = 4096, DM = 2048, T = BATCH * SEQ;
constexpr int NH = 4, DK = 128, DV = 256, CH = 64, NC = SEQ / CH, NBH = BATCH * NH, NCHUNK = NBH * NC;
constexpr int D_IN = 10264, NP1 = 10496, NPROJ = 10240;
constexpr int NE = 32, TOPK = 4, DFF = 2048;
constexpr int P_MAX = T * TOPK + NE * 256;
constexpr float LN_EPS = 1e-5f;
constexpr float DN_ALPHA = 1.18920711500272f;
constexpr float RSQRT_DK = 0.08838834764831845f;
constexpr int PC_MQ = 0, PC_MK = 512, PC_MV = 1024, PC_MO = 2048, PC_GQ = 3072, PC_GK = 3584, PC_GV = 4096, PC_GG = 5120, PC_GATEM = 6144, PC_GATEG = 8192;

constexpr size_t MiB = 1u << 20;
constexpr size_t WS_CTL = 0, CTL_ZERO_BYTES = 1 * MiB;
constexpr size_t WS_BIAS1 = 1 * MiB;
constexpr size_t WS_WIN = 2 * MiB, WS_WBM = 44 * MiB, WS_WBG = 48 * MiB, WS_WOUT = 52 * MiB, WS_WGU = 64 * MiB, WS_WD = 576 * MiB;
constexpr size_t WS_XB = 832 * MiB, WS_PROJ = 960 * MiB, WS_SMALL = 1600 * MiB;
constexpr size_t WS_MSTATE = 1608 * MiB, WS_GSTATE = 1868 * MiB, WS_MPREV = 2124 * MiB, WS_GPREV = 2252 * MiB, WS_MISC = 2380 * MiB;
constexpr size_t WS_YM = 2384 * MiB, WS_YG = 2448 * MiB, WS_T1 = 2512 * MiB, WS_Z = 2768 * MiB, WS_PRE = 2896 * MiB, WS_X1 = 3152 * MiB, WS_X1B = 3408 * MiB;
constexpr size_t WS_XS = 960 * MiB, WS_ACT = 1504 * MiB, WS_OUTS = 2048 * MiB;
constexpr size_t WS_SLOT = 3536 * MiB, WS_ASG = 3540 * MiB, WS_END = 3544 * MiB;
static_assert(WS_WIN + (size_t)NP1 * DM * 2 <= WS_WBM && WS_WGU + (size_t)NE * 4096 * DM * 2 <= WS_WD && WS_WD + (size_t)NE * DM * DM * 2 <= WS_XB, "ws map 1");
static_assert(WS_PROJ + (size_t)T * NPROJ * 2 <= WS_SMALL && WS_MSTATE + (size_t)NCHUNK * 257 * 128 * 4 <= WS_GSTATE && WS_GSTATE + (size_t)NCHUNK * 256 * 128 * 4 <= WS_MPREV, "ws map 2");
static_assert(WS_XS + (size_t)P_MAX * DM * 2 <= WS_ACT && WS_ACT + (size_t)P_MAX * DM * 2 <= WS_OUTS && WS_OUTS + (size_t)P_MAX * DM * 2 <= WS_Z, "ws map 3");
constexpr size_t MISC_NPREV = 0, MISC_MPREV = 1 * MiB, MISC_GEND = 1 * MiB + 65536, MISC_BEND = 1 * MiB + 131072, MISC_GDEC = 2 * MiB;
constexpr int CW_BAR = 4096;
constexpr int CW_CNT = 16384;

constexpr int RING_BYTES = 131072;
constexpr int LDSCTL_OFF = RING_BYTES, MISC_OFF = LDSCTL_OFF + 320;
constexpr int TST_OFF = LDSCTL_OFF + 1024;
constexpr int LDS_BYTES = 147456;

__device__ __forceinline__ float bf2f(unsigned b) { return __builtin_bit_cast(float, b << 16); }
__device__ __forceinline__ float wave_sum(float v) {
#pragma unroll
    for (int o = 1; o < 64; o <<= 1) v += __shfl_xor(v, o);
    return v;
}
__device__ __forceinline__ float wave_max(float v) {
#pragma unroll
    for (int o = 1; o < 64; o <<= 1) v = fmaxf(v, __shfl_xor(v, o));
    return v;
}
__device__ __forceinline__ float logsigmoidf(float x) { return fminf(x, 0.f) - log1pf(expf(-fabsf(x))); }
__device__ __forceinline__ float sigmoid_fast(float x) { return 1.f / (1.f + __expf(-x)); }
__device__ __forceinline__ void unpack8(const v4u r, float (&o)[8]) {
    o[0] = bf2f(r.x & 0xffffu); o[1] = bf2f(r.x >> 16); o[2] = bf2f(r.y & 0xffffu); o[3] = bf2f(r.y >> 16);
    o[4] = bf2f(r.z & 0xffffu); o[5] = bf2f(r.z >> 16); o[6] = bf2f(r.w & 0xffffu); o[7] = bf2f(r.w >> 16);
}

struct KP {
    const float *x, *w_in, *b_in, *conv_w, *conv_b, *w_gla, *b_gla, *m_norm_w, *g_norm_w, *w_bm, *w_bg, *w_out, *ln1_g, *ln1_b, *w_router, *b_router, *w_gu, *b_gu, *w_down, *b_down, *ln2_g, *ln2_b;
    float* out; unsigned char* ws;
};

template <class F> __device__ __forceinline__ void transpose_item(const float* W, int K, int ldw, bf16* WT, int n0, int k0, F srccol, LAS float* scr, int lane) {
    const int sc = srccol(n0 + (lane & 31));
#pragma unroll 8
    for (int i = 0; i < 32; ++i) { const int kk = 2 * i + (lane >> 5); scr[kk * 33 + (lane & 31)] = sc >= 0 ? W[(size_t)(k0 + kk) * ldw + sc] : 0.f; }
    LDS_WAIT(); asm volatile("" ::: "memory");
    const int c = lane & 7;
#pragma unroll
    for (int j = 0; j < 4; ++j) { const int n = (lane >> 3) + 8 * j; const LAS float* s = scr + (8 * c) * 33 + n;
        v4u o; o.x = pk2(s[0 * 33], s[1 * 33]); o.y = pk2(s[2 * 33], s[3 * 33]); o.z = pk2(s[4 * 33], s[5 * 33]); o.w = pk2(s[6 * 33], s[7 * 33]);
        *(GAS v4u*)(WT + (size_t)(n0 + n) * K + k0 + 8 * c) = o; }
    LDS_WAIT(); asm volatile("" ::: "memory");
}
struct ColIdent { __device__ __forceinline__ int operator()(int n) const { return n; } };
struct ColWin { __device__ __forceinline__ int operator()(int n) const {
    if (n < 3072) return n; if (n < 6144) return n + 8; if (n < 10240) return n + 24;
    const int j = n - 10240; if (j < 8) return 3072 + j; if (j < 24) return 6152 + (j - 8); return -1; } };
struct ColGu { __device__ __forceinline__ int operator()(int n) const { const int jt = n >> 8, w = n & 255; return w < 128 ? 128 * jt + w : 2048 + 128 * jt + (w - 128); } };

__device__ __forceinline__ void p0_prologue(const KP& p, LAS unsigned char* lds, int G, int vcu, int wave, int lane) {
    LAS float* scr = (LAS float*)(lds + wave * 16384);
    const int gw = vcu * NWAVES + wave, NGW = G * NWAVES;
    unsigned char* ws = p.ws;
    bf16* WIN = (bf16*)(ws + WS_WIN); bf16* WBM = (bf16*)(ws + WS_WBM); bf16* WBG = (bf16*)(ws + WS_WBG); bf16* WOUT = (bf16*)(ws + WS_WOUT); bf16* WGU = (bf16*)(ws + WS_WGU); bf16* WD = (bf16*)(ws + WS_WD);
    constexpr int I_IN = 32 * (NP1 / 32), I_BM = 16 * 64, I_OUT = 32 * 64, I_GU = 32 * 128, I_D = 32 * 64;
    constexpr int NITEMS = I_IN + 2 * I_BM + I_OUT + NE * I_GU + NE * I_D;
    for (int it = gw; it < NITEMS; it += NGW) {
        int r = it;
        if (r < I_IN) { const int nblk = NP1 / 32; transpose_item(p.w_in, DM, D_IN, WIN, 32 * (r % nblk), 64 * (r / nblk), ColWin(), scr, lane); continue; } r -= I_IN;
        if (r < I_BM) { transpose_item(p.w_bm, 1024, DM, WBM, 32 * (r % 64), 64 * (r / 64), ColIdent(), scr, lane); continue; } r -= I_BM;
        if (r < I_BM) { transpose_item(p.w_bg, 1024, DM, WBG, 32 * (r % 64), 64 * (r / 64), ColIdent(), scr, lane); continue; } r -= I_BM;
        if (r < I_OUT) { transpose_item(p.w_out, DM, DM, WOUT, 32 * (r % 64), 64 * (r / 64), ColIdent(), scr, lane); continue; } r -= I_OUT;
        if (r < NE * I_GU) { const int e = r / I_GU, q = r % I_GU; transpose_item(p.w_gu + (size_t)e * DM * 4096, DM, 4096, WGU + (size_t)e * 4096 * DM, 32 * (q % 128), 64 * (q / 128), ColGu(), scr, lane); continue; } r -= NE * I_GU;
        { const int e = r / I_D, q = r % I_D; transpose_item(p.w_down + (size_t)e * DM * DM, DM, DM, WD + (size_t)e * DM * DM, 32 * (q % 64), 64 * (q / 64), ColIdent(), scr, lane); }
    }
    bf16* XB = (bf16*)(ws + WS_XB);
    for (int m = gw; m < T; m += NGW) {
        const GAS f32x4* xr = (const GAS f32x4*)(p.x + (size_t)m * DM) + lane;
        GAS unsigned long long* o8 = (GAS unsigned long long*)(XB + (size_t)m * DM) + lane;
#pragma unroll
        for (int j = 0; j < 8; ++j) { const f32x4 v = xr[64 * j]; o8[64 * j] = (unsigned long long)pk2(v.x, v.y) | ((unsigned long long)pk2(v.z, v.w) << 32); }
    }
    float* B1 = (float*)(ws + WS_BIAS1);
    for (int n = gw * 64 + lane; n < NP1; n += NGW * 64) { const int sc = ColWin()(n); B1[n] = sc >= 0 ? p.b_in[sc] : 0.f; }
}

struct EpiProj {
    static constexpr bool PERM = true, AFTER_DRAIN = false;
    bf16* PROJ; float* SMALL; const float* bias;
    __device__ __forceinline__ void operator()(const pg8::f32x4 (&acc)[2][2][4][2], const pg8::Unit& u, int wr, int wc, int fr, int fq) const {
        const int row0 = u.pm * 256 + wr * 64 + fr;
        if (u.pn == 40) {
            if (wc == 0) {
                const float* bp = bias + 10240 + 8 * fq;
                const f32x4 b0 = *(const f32x4*)bp, b1 = *(const f32x4*)(bp + 4);
#pragma unroll
                for (int ai = 0; ai < 2; ++ai)
#pragma unroll
                    for (int m = 0; m < 4; ++m) { float* rp = SMALL + (size_t)(row0 + ai * 128 + m * 16) * 32 + 8 * fq;
                        *(f32x4*)rp = acc[ai][0][m][0] + b0; *(f32x4*)(rp + 4) = acc[ai][0][m][1] + b1; }
            }
            return;
        }
        const int pn = u.pn;
        const int act = (pn >= 8 && pn < 12) || pn >= 24 ? 1 : ((pn >= 20 && pn < 24) ? 2 : 0);
        const int col0 = pn * 256 + wc * 32 + 8 * fq;
        f32x4 bv[2][2];
#pragma unroll
        for (int bj = 0; bj < 2; ++bj)
#pragma unroll
            for (int n = 0; n < 2; ++n) bv[bj][n] = *(const f32x4*)(bias + col0 + bj * 128 + 4 * n);
#pragma unroll
        for (int ai = 0; ai < 2; ++ai)
#pragma unroll
            for (int m = 0; m < 4; ++m) { bf16* rowp = PROJ + (size_t)(row0 + ai * 128 + m * 16) * NPROJ + col0;
#pragma unroll
                for (int bj = 0; bj < 2; ++bj) { f32x4 v0 = acc[ai][bj][m][0] + bv[bj][0], v1 = acc[ai][bj][m][1] + bv[bj][1];
                    if (act) {
#pragma unroll
                        for (int j = 0; j < 4; ++j) { const float s0 = sigmoid_fast(v0[j]), s1 = sigmoid_fast(v1[j]); v0[j] = act == 1 ? s0 : v0[j] * s0; v1[j] = act == 1 ? s1 : v1[j] * s1; }
                    }
                    pg8::u32x4 w; w.x = pg8::cvt_pk_bf16(v0[0], v0[1]); w.y = pg8::cvt_pk_bf16(v0[2], v0[3]); w.z = pg8::cvt_pk_bf16(v1[0], v1[1]); w.w = pg8::cvt_pk_bf16(v1[2], v1[3]);
                    *(pg8::u32x4*)(rowp + bj * 128) = w; } }
    }
};
struct EpiBranchM {
    static constexpr bool PERM = false, AFTER_DRAIN = false;
    float* T1; const bf16* PROJ;
    __device__ __forceinline__ void operator()(const pg8::f32x4 (&acc)[2][2][4][2], const pg8::Unit& u, int wr, int wc, int fr, int fq) const {
        const int row0 = u.pm * 256 + wr * 64 + fr, col0 = u.pn * 256 + wc * 32 + 4 * fq;
#pragma unroll
        for (int ai = 0; ai < 2; ++ai)
#pragma unroll
            for (int m = 0; m < 4; ++m) { const size_t row = (size_t)(row0 + ai * 128 + m * 16);
#pragma unroll
                for (int bj = 0; bj < 2; ++bj)
#pragma unroll
                    for (int n = 0; n < 2; ++n) { const int col = col0 + bj * 128 + n * 16;
                        const unsigned long long g = *(const unsigned long long*)(PROJ + row * NPROJ + PC_GATEM + col);
                        f32x4 gv; gv.x = bf2f((unsigned)g & 0xffffu); gv.y = bf2f(((unsigned)g) >> 16); gv.z = bf2f((unsigned)(g >> 32) & 0xffffu); gv.w = bf2f((unsigned)(g >> 48));
                        *(f32x4*)(T1 + row * DM + col) = acc[ai][bj][m][n] * gv; } }
    }
};
struct EpiBranchG {
    static constexpr bool PERM = true, AFTER_DRAIN = false;
    bf16* Z; const float* T1; const bf16* PROJ;
    __device__ __forceinline__ void operator()(const pg8::f32x4 (&acc)[2][2][4][2], const pg8::Unit& u, int wr, int wc, int fr, int fq) const {
        const int row0 = u.pm * 256 + wr * 64 + fr, col0 = u.pn * 256 + wc * 32 + 8 * fq;
#pragma unroll
        for (int ai = 0; ai < 2; ++ai)
#pragma unroll
            for (int m = 0; m < 4; ++m) { const size_t row = (size_t)(row0 + ai * 128 + m * 16);
#pragma unroll
                for (int bj = 0; bj < 2; ++bj) { const int col = col0 + bj * 128;
                    const v4u g = *(const v4u*)(PROJ + row * NPROJ + PC_GATEG + col); float gf[8]; unpack8(g, gf);
                    const f32x4 t0 = *(const f32x4*)(T1 + row * DM + col), t1 = *(const f32x4*)(T1 + row * DM + col + 4);
                    const f32x4 a0 = acc[ai][bj][m][0], a1 = acc[ai][bj][m][1];
                    pg8::u32x4 w; w.x = pg8::cvt_pk_bf16(t0[0] + gf[0] * a0[0], t0[1] + gf[1] * a0[1]); w.y = pg8::cvt_pk_bf16(t0[2] + gf[2] * a0[2], t0[3] + gf[3] * a0[3]);
                    w.z = pg8::cvt_pk_bf16(t1[0] + gf[4] * a1[0], t1[1] + gf[5] * a1[1]); w.w = pg8::cvt_pk_bf16(t1[2] + gf[6] * a1[2], t1[3] + gf[7] * a1[3]);
                    *(pg8::u32x4*)(Z + row * DM + col) = w; } }
    }
};
struct EpiMix {
    static constexpr bool PERM = false, AFTER_DRAIN = false;
    float* PRE; const float* X;
    __device__ __forceinline__ void operator()(const pg8::f32x4 (&acc)[2][2][4][2], const pg8::Unit& u, int wr, int wc, int fr, int fq) const {
        const int row0 = u.pm * 256 + wr * 64 + fr, col0 = u.pn * 256 + wc * 32 + 4 * fq;
#pragma unroll
        for (int ai = 0; ai < 2; ++ai)
#pragma unroll
            for (int m = 0; m < 4; ++m) { const size_t row = (size_t)(row0 + ai * 128 + m * 16);
#pragma unroll
                for (int bj = 0; bj < 2; ++bj)
#pragma unroll
                    for (int n = 0; n < 2; ++n) { const int col = col0 + bj * 128 + n * 16;
                        const f32x4 xv = *(const f32x4*)(X + row * DM + col);
                        *(f32x4*)(PRE + row * DM + col) = xv * DN_ALPHA + acc[ai][bj][m][n]; } }
    }
};
struct EpiSwiglu {
    static constexpr bool PERM = true, AFTER_DRAIN = false;
    bf16* ACT; const float* b_gu;
    __device__ __forceinline__ void operator()(const pg8::f32x4 (&acc)[2][2][4][2], const pg8::Unit& u, int wr, int wc, int fr, int fq) const {
        const int e = u.pn >> 4, jt = u.pn & 15;
        const int row0 = u.pm * 256 + wr * 64 + fr, c0 = 128 * jt + wc * 32 + 8 * fq;
        const float* bg = b_gu + (size_t)e * 4096 + c0;
        const f32x4 bg0 = *(const f32x4*)bg, bg1 = *(const f32x4*)(bg + 4), bl0 = *(const f32x4*)(bg + 2048), bl1 = *(const f32x4*)(bg + 2052);
#pragma unroll
        for (int ai = 0; ai < 2; ++ai)
#pragma unroll
            for (int m = 0; m < 4; ++m) { const size_t row = (size_t)(row0 + ai * 128 + m * 16);
                const f32x4 g0 = acc[ai][0][m][0] + bg0, g1 = acc[ai][0][m][1] + bg1, l0 = acc[ai][1][m][0] + bl0, l1 = acc[ai][1][m][1] + bl1;
                float r[8];
#pragma unroll
                for (int j = 0; j < 4; ++j) {
                    const float a = fminf(g0[j], 7.f), b = fminf(fmaxf(l0[j], -7.f), 7.f); r[j] = a * sigmoid_fast(1.702f * a) * (b + 1.f);
                    const float a2 = fminf(g1[j], 7.f), b2 = fminf(fmaxf(l1[j], -7.f), 7.f); r[4 + j] = a2 * sigmoid_fast(1.702f * a2) * (b2 + 1.f); }
                pg8::u32x4 w; w.x = pg8::cvt_pk_bf16(r[0], r[1]); w.y = pg8::cvt_pk_bf16(r[2], r[3]); w.z = pg8::cvt_pk_bf16(r[4], r[5]); w.w = pg8::cvt_pk_bf16(r[6], r[7]);
                *(pg8::u32x4*)(ACT + row * DFF + c0) = w; }
    }
};
struct EpiDown {
    static constexpr bool PERM = true, AFTER_DRAIN = false;
    bf16* OUTS; const float* b_down;
    __device__ __forceinline__ void operator()(const pg8::f32x4 (&acc)[2][2][4][2], const pg8::Unit& u, int wr, int wc, int fr, int fq) const {
        const int e = u.pn >> 3, jt = u.pn & 7;
        const int row0 = u.pm * 256 + wr * 64 + fr, c0 = 256 * jt + wc * 32 + 8 * fq;
        const float* bd = b_down + (size_t)e * DM + c0;
        f32x4 bv[2][2];
#pragma unroll
        for (int bj = 0; bj < 2; ++bj)
#pragma unroll
            for (int n = 0; n < 2; ++n) bv[bj][n] = *(const f32x4*)(bd + bj * 128 + 4 * n);
#pragma unroll
        for (int ai = 0; ai < 2; ++ai)
#pragma unroll
            for (int m = 0; m < 4; ++m) { bf16* rowp = OUTS + (size_t)(row0 + ai * 128 + m * 16) * DM + c0;
#pragma unroll
                for (int bj = 0; bj < 2; ++bj) { const f32x4 v0 = acc[ai][bj][m][0] + bv[bj][0], v1 = acc[ai][bj][m][1] + bv[bj][1];
                    pg8::u32x4 w; w.x = pg8::cvt_pk_bf16(v0[0], v0[1]); w.y = pg8::cvt_pk_bf16(v0[2], v0[3]); w.z = pg8::cvt_pk_bf16(v1[0], v1[1]); w.w = pg8::cvt_pk_bf16(v1[2], v1[3]);
                    *(pg8::u32x4*)(rowp + bj * 128) = w; } }
    }
};
struct MoeOrder {
    const LAS int* tst; int G, c, nN;
    __device__ __forceinline__ bool next(int i, pg8::Unit& u) const {
        const int L = i * G + c; const int total = tst[32] * nN; if (L >= total) return false;
        const int rt = L / nN, nt = L % nN; int e = 0;
#pragma unroll 1
        for (int k = 1; k < 32; ++k) e += (tst[k] <= rt) ? 1 : 0;
        u.pm = rt; u.pn = e * nN + nt; return true;
    }
    __device__ __forceinline__ void a_ready(const pg8::Unit&) const {}
    __device__ __forceinline__ void done(const pg8::Unit&) const {}
};
__device__ __forceinline__ void moe_tables(const gu32* ctl, LAS int* tst, int tid) {
    if (tid < 32) tst[33 + tid] = (int)__hip_atomic_load(ctl + CW_CNT + 64 * tid, RLX_AGENT);
    __syncthreads();
    if (tid == 0) { int a = 0; for (int e = 0; e < 32; ++e) { tst[e] = a; a += (tst[33 + e] + 255) >> 8; } tst[32] = a; }
    __syncthreads();
}

__device__ __forceinline__ void stage_vT(const bf16* PROJ, size_t t0, int vcol, LAS bf16* vT, int tid) {
#pragma unroll
    for (int i = 0; i < 4; ++i) { const int idx = tid + NTHR * i, s = idx >> 5, c8 = idx & 31;
        const v4u r = *(const GAS v4u*)(PROJ + (t0 + s) * NPROJ + vcol + c8 * 8);
        LAS bf16* d = vT + (c8 * 8) * 72 + s;
        d[0 * 72] = (bf16)(r.x & 0xffffu); d[1 * 72] = (bf16)(r.x >> 16); d[2 * 72] = (bf16)(r.y & 0xffffu); d[3 * 72] = (bf16)(r.y >> 16);
        d[4 * 72] = (bf16)(r.z & 0xffffu); d[5 * 72] = (bf16)(r.z >> 16); d[6 * 72] = (bf16)(r.w & 0xffffu); d[7 * 72] = (bf16)(r.w >> 16); }
}
struct ConvW { float w[4][8]; float b[8]; };
__device__ __forceinline__ void load_convw(ConvW& cw, const float* conv_w, const float* conv_b, int ch) {
#pragma unroll
    for (int j = 0; j < 4; ++j) { const f32x4 a = *(const f32x4*)(conv_w + j * 1024 + ch), b = *(const f32x4*)(conv_w + j * 1024 + ch + 4);
        cw.w[j][0] = a.x; cw.w[j][1] = a.y; cw.w[j][2] = a.z; cw.w[j][3] = a.w; cw.w[j][4] = b.x; cw.w[j][5] = b.y; cw.w[j][6] = b.z; cw.w[j][7] = b.w; }
    const f32x4 a = *(const f32x4*)(conv_b + ch), b = *(const f32x4*)(conv_b + ch + 4);
    cw.b[0] = a.x; cw.b[1] = a.y; cw.b[2] = a.z; cw.b[3] = a.w; cw.b[4] = b.x; cw.b[5] = b.y; cw.b[6] = b.z; cw.b[7] = b.w;
}
__device__ __forceinline__ void conv_silu8(const bf16* src, size_t trow, int pos, const ConvW& cw, float (&o)[8]) {
#pragma unroll
    for (int d = 0; d < 8; ++d) o[d] = cw.b[d];
#pragma unroll
    for (int j = 0; j < 4; ++j) { if (pos - 3 + j >= 0) { const v4u r = *(const GAS v4u*)(src + (trow - 3 + j) * NPROJ); float f[8]; unpack8(r, f);
#pragma unroll
            for (int d = 0; d < 8; ++d) o[d] += cw.w[j][d] * f[d]; } }
#pragma unroll
    for (int d = 0; d < 8; ++d) o[d] = o[d] * sigmoid_fast(o[d]);
}
__device__ __forceinline__ void gla_cum(const KP& p, const float* SMALL, size_t t0, int h, LAS float* cumL, LAS float* tot, LAS float* glr_s, int tid) {
    for (int i = tid; i < 64 * 16; i += NTHR) glr_s[i] = SMALL[(t0 + (i >> 4)) * 32 + 8 + (i & 15)];
    const int dk = tid & 127, sq = tid >> 7;
    float wg[16];
#pragma unroll
    for (int r = 0; r < 16; ++r) wg[r] = p.w_gla[r * 512 + h * 128 + dk];
    const float bgv = p.b_gla[h * 128 + dk];
    __syncthreads();
    float run = 0.f; float loc[16];
#pragma unroll
    for (int i = 0; i < 16; ++i) { const int s = 16 * sq + i; float z = bgv;
#pragma unroll
        for (int r = 0; r < 16; ++r) z += glr_s[s * 16 + r] * wg[r];
        run += logsigmoidf(z) * (1.f / 16.f); loc[i] = run; }
    tot[sq * 128 + dk] = run;
    __syncthreads();
    float off = 0.f;
#pragma unroll
    for (int j = 0; j < 3; ++j) off += (j < sq) ? tot[j * 128 + dk] : 0.f;
#pragma unroll
    for (int i = 0; i < 16; ++i) cumL[(16 * sq + i) * 128 + dk] = loc[i] + off;
    __syncthreads();
}
__device__ __forceinline__ void state_mfma_store(const LAS bf16* vT, const LAS bf16* keT, float* dst, int wave, int lane) {
    const int fr = lane & 15, fq = lane >> 4;
#pragma unroll
    for (int i = 0; i < 2; ++i) { const int dvt = 2 * wave + i;
        bf16x8 a[2];
#pragma unroll
        for (int ks = 0; ks < 2; ++ks) a[ks] = *(const LAS bf16x8*)(vT + (16 * dvt + fr) * 72 + 32 * ks + 8 * fq);
#pragma unroll
        for (int j = 0; j < 8; ++j) { f32x4 acc = {0.f, 0.f, 0.f, 0.f};
#pragma unroll
            for (int ks = 0; ks < 2; ++ks) { const bf16x8 b = *(const LAS bf16x8*)(keT + (16 * j + fr) * 72 + 32 * ks + 8 * fq); acc = __builtin_amdgcn_mfma_f32_16x16x32_bf16(a[ks], b, acc, 0, 0, 0); }
#pragma unroll
            for (int r = 0; r < 4; ++r) dst[(size_t)(16 * dvt + 4 * fq + r) * 128 + 16 * j + fr] = acc[r]; } }
}

template <bool gla> __device__ __forceinline__ void mixer_local_unit(const KP& p, LAS unsigned char* L, int cid, int tid, int lane, int wave) {
    unsigned char* ws = p.ws;
    const bf16* PROJ = (const bf16*)(ws + WS_PROJ); const float* SMALL = (const float*)(ws + WS_SMALL);
    const int bh = cid >> 6, c = cid & 63, b = bh >> 2, h = bh & 3;
    const size_t t0 = (size_t)b * SEQ + c * 64;
    LAS bf16* vT = (LAS bf16*)(L + 0); LAS bf16* keT = (LAS bf16*)(L + 36864);
    LAS float* wexp = (LAS float*)(L + 55296);
    LAS float* cumL = (LAS float*)(L + 57344); LAS float* tot = (LAS float*)(L + 57344 + 32768); LAS float* glr_s = (LAS float*)(L + 57344 + 32768 + 2048);
    if (!gla) {
        if (wave == 0) {
            const float fp = SMALL[(t0 + lane) * 32 + 4 + h], ip = SMALL[(t0 + lane) * 32 + h];
            float bc = logsigmoidf(fp);
#pragma unroll
            for (int o = 1; o < 64; o <<= 1) { const float n = __shfl_up(bc, o); if (lane >= o) bc += n; }
            const float bend = __shfl(bc, 63);
            const float w = bend - bc + ip; const float g = wave_max(w);
            wexp[lane] = expf(w - g);
            if (lane == 0) { ((float*)(ws + WS_MISC + MISC_GEND))[cid] = g; ((float*)(ws + WS_MISC + MISC_BEND))[cid] = bend; }
        }
        stage_vT(PROJ, t0, PC_MV + h * 256, vT, tid);
        __syncthreads();
        { const int d8 = tid & 15; ConvW cw; load_convw(cw, p.conv_w, p.conv_b, 512 + h * 128 + d8 * 8);
#pragma unroll
          for (int i = 0; i < 2; ++i) { const int s = (tid + NTHR * i) >> 4; float o[8]; conv_silu8(PROJ + PC_MK + h * 128 + d8 * 8, t0 + s, c * 64 + s, cw, o);
              const float sc = RSQRT_DK * wexp[s];
#pragma unroll
              for (int d = 0; d < 8; ++d) keT[(d8 * 8 + d) * 72 + s] = (bf16)f2bf(o[d] * sc); } }
        __syncthreads();
        float* dst = (float*)(ws + WS_MSTATE) + (size_t)cid * (257 * 128);
        if (tid < 128) { float sum = 0.f;
#pragma unroll 8
            for (int s = 0; s < 64; ++s) sum += bf2f(keT[tid * 72 + s]);
            dst[256 * 128 + tid] = sum; }
        state_mfma_store(vT, keT, dst, wave, lane);
    } else {
        gla_cum(p, SMALL, t0, h, cumL, tot, glr_s, tid);
        stage_vT(PROJ, t0, PC_GV + h * 256, vT, tid);
        { const int d8 = tid & 15;
#pragma unroll
          for (int i = 0; i < 2; ++i) { const int s = (tid + NTHR * i) >> 4;
              const v4u r = *(const GAS v4u*)(PROJ + (t0 + s) * NPROJ + PC_GK + h * 128 + d8 * 8); float f[8]; unpack8(r, f);
#pragma unroll
              for (int d = 0; d < 8; ++d) { const int dk = d8 * 8 + d; keT[dk * 72 + s] = (bf16)f2bf(f[d] * expf(cumL[63 * 128 + dk] - cumL[s * 128 + dk])); } } }
        if (tid < 128) ((float*)(ws + WS_MISC + MISC_GDEC))[(size_t)cid * 128 + tid] = expf(cumL[63 * 128 + tid]);
        __syncthreads();
        state_mfma_store(vT, keT, (float*)(ws + WS_GSTATE) + (size_t)cid * (256 * 128), wave, lane);
    }
    __syncthreads();
}

__device__ __forceinline__ void scan_phase(const KP& p, LAS unsigned char* L, int G, int tid) {
    unsigned char* ws = p.ws;
    LAS float* sg = (LAS float*)L; LAS float* sbe = sg + 2048; LAS float* sa = sg + 4096; LAS float* sc = sg + 6144;
    const float* GEND = (const float*)(ws + WS_MISC + MISC_GEND); const float* BEND = (const float*)(ws + WS_MISC + MISC_BEND);
    float* MPREV = (float*)(ws + WS_MISC + MISC_MPREV); float* NPREV = (float*)(ws + WS_MISC + MISC_NPREV);
    for (int i = tid; i < 2048; i += NTHR) { sg[i] = GEND[i]; sbe[i] = BEND[i]; }
    __syncthreads();
    if (tid < 32) { float m = 0.f;
        for (int c = 0; c < 64; ++c) { const int id = tid * 64 + c; const float g = sg[id], be = sbe[id];
            if (blockIdx.x == 0) MPREV[id] = m;
            const float mn = fmaxf(be + m, g); sa[id] = expf(be + m - mn); sc[id] = expf(g - mn); m = mn; } }
    __syncthreads();
    const int NT = G * NTHR, gt = blockIdx.x * NTHR + tid;
    const float* MST = (const float*)(ws + WS_MSTATE); bf16* MPC = (bf16*)(ws + WS_MPREV);
    for (int e = gt; e < NBH * 32896; e += NT) { const int bh = e / 32896, idx = e % 32896;
        const float* src = MST + (size_t)bh * 64 * 32896 + idx; float st = 0.f;
#pragma unroll 1
        for (int c0 = 0; c0 < 64; c0 += 16) { float d[16];
#pragma unroll
            for (int j = 0; j < 16; ++j) d[j] = src[(size_t)(c0 + j) * 32896];
#pragma unroll
            for (int j = 0; j < 16; ++j) { const int cid = bh * 64 + c0 + j;
                if (idx < 32768) MPC[(size_t)cid * 32768 + idx] = (bf16)f2bf(st); else NPREV[cid * 128 + idx - 32768] = st;
                st = sa[cid] * st + sc[cid] * d[j]; } } }
    const float* GST = (const float*)(ws + WS_GSTATE); bf16* GPC = (bf16*)(ws + WS_GPREV); const float* GDEC = (const float*)(ws + WS_MISC + MISC_GDEC);
    for (int e = gt; e < NBH * 32768; e += NT) { const int bh = e >> 15, idx = e & 32767, dk = idx & 127;
        const float* src = GST + (size_t)bh * 64 * 32768 + idx; const float* dsrc = GDEC + (size_t)bh * 64 * 128 + dk; float st = 0.f;
#pragma unroll 1
        for (int c0 = 0; c0 < 64; c0 += 16) { float d[16], dc[16];
#pragma unroll
            for (int j = 0; j < 16; ++j) { d[j] = src[(size_t)(c0 + j) * 32768]; dc[j] = dsrc[(c0 + j) * 128]; }
#pragma unroll
            for (int j = 0; j < 16; ++j) { const int cid = bh * 64 + c0 + j; GPC[(size_t)cid * 32768 + idx] = (bf16)f2bf(st); st = dc[j] * st + d[j]; } } }
}

template <bool gla> __device__ __forceinline__ void mixer_out_unit(const KP& p, LAS unsigned char* L, int cid, int tid, int lane, int wave) {
    unsigned char* ws = p.ws;
    const bf16* PROJ = (const bf16*)(ws + WS_PROJ); const float* SMALL = (const float*)(ws + WS_SMALL);
    const int bh = cid >> 6, c = cid & 63, b = bh >> 2, h = bh & 3;
    const size_t t0 = (size_t)b * SEQ + c * 64;
    const int fr = lane & 15, fq = lane >> 4;
    LAS bf16* q = (LAS bf16*)(L + 0); LAS bf16* k = (LAS bf16*)(L + 17408); LAS bf16* vT = (LAS bf16*)(L + 34816); LAS bf16* Sb = (LAS bf16*)(L + 71680);
    LAS float* sb = (LAS float*)(L + 80896); LAS float* sli = sb + 64; LAS float* smt = sb + 128; LAS float* sdec = sb + 192; LAS float* sden = sb + 256; LAS float* snp = sb + 320;
    LAS float* cumL = (LAS float*)(L + 83968); LAS float* tot = (LAS float*)(L + 83968 + 32768); LAS float* glr_s = (LAS float*)(L + 83968 + 32768 + 2048);
    LAS float* hbuf = (LAS float*)L;
    if (!gla) {
        if (wave == 0) {
            const float fp = SMALL[(t0 + lane) * 32 + 4 + h], ip = SMALL[(t0 + lane) * 32 + h];
            float bc = logsigmoidf(fp);
#pragma unroll
            for (int o = 1; o < 64; o <<= 1) { const float n = __shfl_up(bc, o); if (lane >= o) bc += n; }
            float pm = ip - bc;
#pragma unroll
            for (int o = 1; o < 64; o <<= 1) { const float n = __shfl_up(pm, o); if (lane >= o) pm = fmaxf(pm, n); }
            const float mprev = ((const float*)(ws + WS_MISC + MISC_MPREV))[cid];
            const float mt = bc + fmaxf(mprev, pm);
            sb[lane] = bc; sli[lane] = ip; smt[lane] = mt; sdec[lane] = expf(bc + mprev - mt);
        } else if (tid < 192) snp[tid - 64] = ((const float*)(ws + WS_MISC + MISC_NPREV))[cid * 128 + tid - 64];
        stage_vT(PROJ, t0, PC_MV + h * 256, vT, tid);
        { const int d8 = tid & 15;
#pragma unroll 1
          for (int qk = 0; qk < 2; ++qk) { ConvW cw; load_convw(cw, p.conv_w, p.conv_b, qk * 512 + h * 128 + d8 * 8);
              const float sc = qk ? RSQRT_DK : 1.f; LAS bf16* dstb = qk ? k : q;
#pragma unroll 1
              for (int i = 0; i < 2; ++i) { const int s = (tid + NTHR * i) >> 4; float o[8]; conv_silu8(PROJ + (qk ? PC_MK : PC_MQ) + h * 128 + d8 * 8, t0 + s, c * 64 + s, cw, o);
                  v4u w; w.x = pk2(o[0] * sc, o[1] * sc); w.y = pk2(o[2] * sc, o[3] * sc); w.z = pk2(o[4] * sc, o[5] * sc); w.w = pk2(o[6] * sc, o[7] * sc);
                  *(LAS v4u*)(dstb + s * 136 + d8 * 8) = w; } } }
    } else {
        gla_cum(p, SMALL, t0, h, cumL, tot, glr_s, tid);
        stage_vT(PROJ, t0, PC_GV + h * 256, vT, tid);
        { const int d8 = tid & 15;
#pragma unroll
          for (int i = 0; i < 2; ++i) { const int s = (tid + NTHR * i) >> 4;
              const v4u rq = *(const GAS v4u*)(PROJ + (t0 + s) * NPROJ + PC_GQ + h * 128 + d8 * 8), rk = *(const GAS v4u*)(PROJ + (t0 + s) * NPROJ + PC_GK + h * 128 + d8 * 8);
              float fq8[8], fk8[8]; unpack8(rq, fq8); unpack8(rk, fk8);
#pragma unroll
              for (int d = 0; d < 8; ++d) { const float cu = cumL[s * 128 + d8 * 8 + d]; fq8[d] *= RSQRT_DK * expf(cu); fk8[d] *= expf(-cu); }
              v4u w; w.x = pk2(fq8[0], fq8[1]); w.y = pk2(fq8[2], fq8[3]); w.z = pk2(fq8[4], fq8[5]); w.w = pk2(fq8[6], fq8[7]); *(LAS v4u*)(q + s * 136 + d8 * 8) = w;
              w.x = pk2(fk8[0], fk8[1]); w.y = pk2(fk8[2], fk8[3]); w.z = pk2(fk8[4], fk8[5]); w.w = pk2(fk8[6], fk8[7]); *(LAS v4u*)(k + s * 136 + d8 * 8) = w; } }
    }
    __syncthreads();
    { const int tt = wave >> 1;
      bf16x8 a[4];
#pragma unroll
      for (int ks = 0; ks < 4; ++ks) a[ks] = *(const LAS bf16x8*)(q + (16 * tt + fr) * 136 + 32 * ks + 8 * fq);
#pragma unroll
      for (int i = 0; i < 2; ++i) { const int st = 2 * (wave & 1) + i; f32x4 acc = {0.f, 0.f, 0.f, 0.f};
#pragma unroll
          for (int ks = 0; ks < 4; ++ks) { const bf16x8 bb = *(const LAS bf16x8*)(k + (16 * st + fr) * 136 + 32 * ks + 8 * fq); acc = __builtin_amdgcn_mfma_f32_16x16x32_bf16(a[ks], bb, acc, 0, 0, 0); }
          const int s = 16 * st + fr;
#pragma unroll
          for (int r = 0; r < 4; ++r) { const int t = 16 * tt + 4 * fq + r; float wgt;
              if (!gla) wgt = (s <= t) ? expf(sb[t] - sb[s] + sli[s] - smt[t]) : 0.f; else wgt = (s <= t) ? 1.f : 0.f;
              Sb[t * 72 + s] = (bf16)f2bf(acc[r] * wgt); } } }
    __syncthreads();
    if (!gla) {
#pragma unroll 1
        for (int i = 0; i < 8; ++i) { const int t = 8 * wave + i;
            const float ssum = wave_sum(bf2f(Sb[t * 72 + lane]));
            const float qn = wave_sum(bf2f(q[t * 136 + lane]) * snp[lane] + bf2f(q[t * 136 + 64 + lane]) * snp[64 + lane]);
            const float den = ssum + sdec[t] * qn;
            if (lane == 0) sden[t] = 1.f / fmaxf(fabsf(den), expf(-smt[t])); }
        __syncthreads();
    }
    f32x4 acc1[8];
    const int tt2 = wave >> 1, dvh = wave & 1;
    float den4[4];
    { const bf16* CT = (const bf16*)(ws + (gla ? WS_GPREV : WS_MPREV)) + (size_t)cid * 32768;
      bf16x8 aq[4], as2[2]; float dec4[4];
#pragma unroll
      for (int ks = 0; ks < 4; ++ks) aq[ks] = *(const LAS bf16x8*)(q + (16 * tt2 + fr) * 136 + 32 * ks + 8 * fq);
#pragma unroll
      for (int ks = 0; ks < 2; ++ks) as2[ks] = *(const LAS bf16x8*)(Sb + (16 * tt2 + fr) * 72 + 32 * ks + 8 * fq);
#pragma unroll
      for (int r = 0; r < 4; ++r) { dec4[r] = gla ? 1.f : sdec[16 * tt2 + 4 * fq + r]; den4[r] = gla ? 1.f : sden[16 * tt2 + 4 * fq + r]; }
#pragma unroll
      for (int jj = 0; jj < 8; ++jj) { const int dvt = 8 * dvh + jj;
          bf16x8 bv[2], bc[4];
#pragma unroll
          for (int ks = 0; ks < 4; ++ks) bc[ks] = *(const GAS bf16x8*)(CT + (16 * dvt + fr) * 128 + 32 * ks + 8 * fq);
#pragma unroll
          for (int ks = 0; ks < 2; ++ks) bv[ks] = *(const LAS bf16x8*)(vT + (16 * dvt + fr) * 72 + 32 * ks + 8 * fq);
          f32x4 x2 = {0.f, 0.f, 0.f, 0.f};
#pragma unroll
          for (int ks = 0; ks < 4; ++ks) x2 = __builtin_amdgcn_mfma_f32_16x16x32_bf16(aq[ks], bc[ks], x2, 0, 0, 0);
#pragma unroll
          for (int r = 0; r < 4; ++r) x2[r] *= dec4[r];
#pragma unroll
          for (int ks = 0; ks < 2; ++ks) x2 = __builtin_amdgcn_mfma_f32_16x16x32_bf16(as2[ks], bv[ks], x2, 0, 0, 0);
          acc1[jj] = x2;
          __builtin_amdgcn_sched_barrier(0); } }
    __syncthreads();
#pragma unroll
    for (int jj = 0; jj < 8; ++jj) { const int dv = 16 * (8 * dvh + jj) + fr;
#pragma unroll
        for (int r = 0; r < 4; ++r) hbuf[(16 * tt2 + 4 * fq + r) * 260 + dv] = acc1[jj][r] * den4[r]; }
    __syncthreads();
    { const float* nw = (gla ? p.g_norm_w : p.m_norm_w) + h * 256 + 4 * lane; const f32x4 wv = *(const f32x4*)nw;
      bf16* Y = (bf16*)(ws + (gla ? WS_YG : WS_YM));
#pragma unroll 1
      for (int i = 0; i < 8; ++i) { const int t = 8 * wave + i;
          const f32x4 v = *(const LAS f32x4*)(hbuf + t * 260 + 4 * lane);
          const unsigned long long gq = *(const GAS unsigned long long*)(PROJ + (t0 + t) * NPROJ + (gla ? PC_GG : PC_MO) + h * 256 + 4 * lane);
          f32x4 gv; gv.x = bf2f((unsigned)gq & 0xffffu); gv.y = bf2f(((unsigned)gq) >> 16); gv.z = bf2f((unsigned)(gq >> 32) & 0xffffu); gv.w = bf2f((unsigned)(gq >> 48));
          f32x4 o;
          if (!gla) { const float mean = wave_sum((v.x + v.y) + (v.z + v.w)) * (1.f / 256.f); const f32x4 d = v - mean;
              const float var = wave_sum((d.x * d.x + d.y * d.y) + (d.z * d.z + d.w * d.w)) * (1.f / 256.f); o = d * (1.f / sqrtf(var + LN_EPS)); }
          else { const float ms = wave_sum((v.x * v.x + v.y * v.y) + (v.z * v.z + v.w * v.w)) * (1.f / 256.f); o = v * (1.f / sqrtf(ms + LN_EPS)); }
          o = o * wv * gv;
          *(GAS unsigned long long*)(Y + (t0 + t) * 1024 + h * 256 + 4 * lane) = (unsigned long long)pk2(o.x, o.y) | ((unsigned long long)pk2(o.z, o.w) << 32); } }
    __syncthreads();
}

__device__ __forceinline__ void ln_router_phase(const KP& p, LAS unsigned char* lds, gu32* ctl, int G, int vcu, int wave, int lane) {
    unsigned char* ws = p.ws;
    LAS f32x4* xrow = (LAS f32x4*)(lds + wave * 8192);
    const float* PRE = (const float*)(ws + WS_PRE); float* X1 = (float*)(ws + WS_X1); bf16* X1B = (bf16*)(ws + WS_X1B);
    int* SLOT = (int*)(ws + WS_SLOT); int* ASG_E = (int*)(ws + WS_ASG); int* ASG_R = ASG_E + T * 4; float* ASG_G = (float*)(ASG_R + T * 4);
    const int gw = vcu * NWAVES + wave, NGW = G * NWAVES;
    for (int m = gw; m < T; m += NGW) {
        const GAS f32x4* xr = (const GAS f32x4*)(PRE + (size_t)m * DM) + lane;
        f32x4 v[8]; float s = 0.f;
#pragma unroll
        for (int j = 0; j < 8; ++j) { v[j] = xr[64 * j]; s += (v[j].x + v[j].y) + (v[j].z + v[j].w); }
        const float mean = wave_sum(s) * (1.f / DM); float s2 = 0.f;
#pragma unroll
        for (int j = 0; j < 8; ++j) { v[j] = v[j] - mean; s2 += (v[j].x * v[j].x + v[j].y * v[j].y) + (v[j].z * v[j].z + v[j].w * v[j].w); }
        const float rstd = 1.f / sqrtf(wave_sum(s2) * (1.f / DM) + LN_EPS);
        GAS f32x4* xo = (GAS f32x4*)(X1 + (size_t)m * DM) + lane; GAS unsigned long long* xb = (GAS unsigned long long*)(X1B + (size_t)m * DM) + lane;
#pragma unroll
        for (int j = 0; j < 8; ++j) { const f32x4 g = *((const GAS f32x4*)p.ln1_g + lane + 64 * j), bb = *((const GAS f32x4*)p.ln1_b + lane + 64 * j);
            v[j] = v[j] * rstd * g + bb; xo[64 * j] = v[j]; xb[64 * j] = (unsigned long long)pk2(v[j].x, v[j].y) | ((unsigned long long)pk2(v[j].z, v[j].w) << 32); }
        float lg[32];
#pragma unroll
        for (int e = 0; e < 32; ++e) lg[e] = 0.f;
#pragma unroll
        for (int j = 0; j < 8; ++j) xrow[64 * j + lane] = v[j];
        LDS_WAIT(); asm volatile("" ::: "memory");
#pragma unroll 1
        for (int j = 0; j < 8; ++j) { const f32x4 xv4 = xrow[64 * j + lane];
#pragma unroll
            for (int qd = 0; qd < 4; ++qd) { const float xv = xv4[qd]; const GAS f32x4* wr = (const GAS f32x4*)(p.w_router + (size_t)(4 * lane + 256 * j + qd) * 32);
#pragma unroll
                for (int e4 = 0; e4 < 8; ++e4) { const f32x4 w = wr[e4]; lg[4 * e4] += xv * w.x; lg[4 * e4 + 1] += xv * w.y; lg[4 * e4 + 2] += xv * w.z; lg[4 * e4 + 3] += xv * w.w; } } }
#pragma unroll
        for (int e = 0; e < 32; ++e) lg[e] = wave_sum(lg[e]) + p.b_router[e];
        int sel[4]; float val[4];
#pragma unroll
        for (int kk = 0; kk < 4; ++kk) { float best = -INFINITY; int bi = 0;
#pragma unroll
            for (int e = 0; e < 32; ++e) { if (lg[e] > best) { best = lg[e]; bi = e; } }
            sel[kk] = bi; val[kk] = best;
#pragma unroll
            for (int e = 0; e < 32; ++e) lg[e] = (e == bi) ? -INFINITY : lg[e]; }
        float ex[4]; float es = 0.f;
#pragma unroll
        for (int kk = 0; kk < 4; ++kk) { ex[kk] = expf(val[kk] - val[0]); es += ex[kk]; }
        if (lane < 4) { const int e = lane == 0 ? sel[0] : lane == 1 ? sel[1] : lane == 2 ? sel[2] : sel[3]; const float g = (lane == 0 ? ex[0] : lane == 1 ? ex[1] : lane == 2 ? ex[2] : ex[3]) / es;
            const unsigned rank = __hip_atomic_fetch_add(ctl + CW_CNT + 64 * e, 1u, RLX_AGENT);
            SLOT[(size_t)e * T + rank] = m; ASG_E[m * 4 + lane] = e; ASG_R[m * 4 + lane] = (int)rank; ASG_G[m * 4 + lane] = g; }
    }
}

__device__ __forceinline__ void gather_phase(const KP& p, const LAS int* tst, int G, int vcu, int wave, int lane) {
    unsigned char* ws = p.ws;
    const bf16* X1B = (const bf16*)(ws + WS_X1B); bf16* XS = (bf16*)(ws + WS_XS); const int* SLOT = (const int*)(ws + WS_SLOT);
    const int gw = vcu * NWAVES + wave, NGW = G * NWAVES; const int P = tst[32] * 256;
    for (int r = gw; r < P; r += NGW) { const int rt = r >> 8; int e = 0;
#pragma unroll 1
        for (int kk = 1; kk < 32; ++kk) e += (tst[kk] <= rt) ? 1 : 0;
        const int ri = r - tst[e] * 256; GAS v4u* dst = (GAS v4u*)(XS + (size_t)r * DM) + lane;
        if (ri < tst[33 + e]) { const int tok = SLOT[(size_t)e * T + ri]; const GAS v4u* src = (const GAS v4u*)(X1B + (size_t)tok * DM) + lane;
#pragma unroll
            for (int j = 0; j < 4; ++j) dst[64 * j] = src[64 * j]; }
        else {
#pragma unroll
            for (int j = 0; j < 4; ++j) dst[64 * j] = (v4u){0u, 0u, 0u, 0u}; } }
}

__device__ __forceinline__ void final_phase(const KP& p, const LAS int* tst, int G, int vcu, int wave, int lane) {
    unsigned char* ws = p.ws;
    const float* X1 = (const float*)(ws + WS_X1); const bf16* OUTS = (const bf16*)(ws + WS_OUTS);
    const int* ASG_E = (const int*)(ws + WS_ASG); const int* ASG_R = ASG_E + T * 4; const float* ASG_G = (const float*)(ASG_R + T * 4);
    const int gw = vcu * NWAVES + wave, NGW = G * NWAVES;
    for (int m = gw; m < T; m += NGW) {
        f32x4 v[8]; const GAS f32x4* xr = (const GAS f32x4*)(X1 + (size_t)m * DM) + lane;
#pragma unroll
        for (int j = 0; j < 8; ++j) v[j] = xr[64 * j] * DN_ALPHA;
#pragma unroll 1
        for (int kk = 0; kk < 4; ++kk) { const int e = ASG_E[m * 4 + kk], rk = ASG_R[m * 4 + kk]; const float g = ASG_G[m * 4 + kk];
            const size_t row = (size_t)tst[e] * 256 + rk; const GAS unsigned long long* orow = (const GAS unsigned long long*)(OUTS + row * DM) + lane;
#pragma unroll
            for (int j = 0; j < 8; ++j) { const unsigned long long w = orow[64 * j];
                v[j].x += g * bf2f((unsigned)w & 0xffffu); v[j].y += g * bf2f(((unsigned)w) >> 16); v[j].z += g * bf2f((unsigned)(w >> 32) & 0xffffu); v[j].w += g * bf2f((unsigned)(w >> 48)); } }
        float s = 0.f;
#pragma unroll
        for (int j = 0; j < 8; ++j) s += (v[j].x + v[j].y) + (v[j].z + v[j].w);
        const float mean = wave_sum(s) * (1.f / DM); float s2 = 0.f;
#pragma unroll
        for (int j = 0; j < 8; ++j) { v[j] = v[j] - mean; s2 += (v[j].x * v[j].x + v[j].y * v[j].y) + (v[j].z * v[j].z + v[j].w * v[j].w); }
        const float rstd = 1.f / sqrtf(wave_sum(s2) * (1.f / DM) + LN_EPS);
        GAS f32x4* xo = (GAS f32x4*)(p.out + (size_t)m * DM) + lane;
#pragma unroll
        for (int j = 0; j < 8; ++j) { const f32x4 g = *((const GAS f32x4*)p.ln2_g + lane + 64 * j), bb = *((const GAS f32x4*)p.ln2_b + lane + 64 * j); xo[64 * j] = v[j] * rstd * g + bb; }
    }
}

constexpr int N_PHASES = 13;
#ifndef MK_ONE_LAUNCH
#define MK_ONE_LAUNCH 0
#endif
struct Args { const float* in[22]; float* out; unsigned char* ws; int ph_lo, ph_hi; };
__global__ void __launch_bounds__(NTHR, 2) fwd(Args args) {
    extern __shared__ __attribute__((aligned(16))) unsigned char lds_raw[];
    LAS unsigned char* lds = (LAS unsigned char*)lds_raw;
    volatile LAS unsigned* MISC = (volatile LAS unsigned*)(lds + MISC_OFF);
    const int tid = threadIdx.x, lane = tid & 63, wave = __builtin_amdgcn_readfirstlane(tid >> 6);
    const int G = gridDim.x; const int bx = blockIdx.x; const int vcu = (G % 8 == 0) ? (bx % 8) * (G / 8) + bx / 8 : bx;
    KP p; p.x = args.in[0]; p.w_in = args.in[1]; p.b_in = args.in[2]; p.conv_w = args.in[3]; p.conv_b = args.in[4]; p.w_gla = args.in[5]; p.b_gla = args.in[6]; p.m_norm_w = args.in[7]; p.g_norm_w = args.in[8];
    p.w_bm = args.in[9]; p.w_bg = args.in[10]; p.w_out = args.in[11]; p.ln1_g = args.in[12]; p.ln1_b = args.in[13]; p.w_router = args.in[14]; p.b_router = args.in[15]; p.w_gu = args.in[16]; p.b_gu = args.in[17];
    p.w_down = args.in[18]; p.b_down = args.in[19]; p.ln2_g = args.in[20]; p.ln2_b = args.in[21]; p.out = args.out; p.ws = args.ws;
    unsigned char* ws = args.ws;
    gu32* ctl = (gu32*)(ws + WS_CTL);
    for (int u = tid; u < (LDS_BYTES - LDSCTL_OFF) / 4; u += NTHR) ((LAS unsigned*)(lds + LDSCTL_OFF))[u] = 0u;
    __syncthreads();
    const int lo = args.ph_lo, hi = args.ph_hi;
    XcdBarrier bar; bar.bar = (unsigned*)(ctl + CW_BAR); bar.x = 0; bar.st = nullptr;
    if (hi - lo > 1) bar = xcd_barrier_post((unsigned*)(ctl + CW_BAR), MISC + 8);
#ifndef PHASE_MASK
#define PHASE_MASK 0xffffffffu
#endif
#define IN(k) (((PHASE_MASK >> (k)) & 1u) && lo <= (k) && (k) < hi)
#define SEAM(k) do { if (IN(k) && IN((k) + 1)) xcd_barrier(bar); } while (0)
    LAS int* tst = (LAS int*)(lds + TST_OFF);

    if (IN(0)) { p0_prologue(p, lds, G, vcu, wave, lane); } SEAM(0);
    if (IN(1)) {
        pg8::Gemm g{(const pg8::bf16_t*)(ws + WS_XB), (const pg8::bf16_t*)(ws + WS_WIN), T, NP1, DM}; pg8::StaticOrder S; S.init(T, NP1, G, bx);
        EpiProj E{(bf16*)(ws + WS_PROJ), (float*)(ws + WS_SMALL), (const float*)(ws + WS_BIAS1)};
        pg8::gemm_phase<EpiProj, pg8::StaticOrder, true, true>(lds, g, S, E);
    } SEAM(1);
    if (IN(2)) { for (int u = bx; u < NCHUNK; u += G) mixer_local_unit<false>(p, lds, u, tid, lane, wave);
                 for (int u = bx; u < NCHUNK; u += G) mixer_local_unit<true>(p, lds, u, tid, lane, wave); } SEAM(2);
    if (IN(3)) { scan_phase(p, lds, G, tid); } SEAM(3);
    if (IN(4)) { for (int u = bx; u < NCHUNK; u += G) mixer_out_unit<false>(p, lds, u, tid, lane, wave);
                 for (int u = bx; u < NCHUNK; u += G) mixer_out_unit<true>(p, lds, u, tid, lane, wave); } SEAM(4);
    if (IN(5)) {
        pg8::Gemm g{(const pg8::bf16_t*)(ws + WS_YM), (const pg8::bf16_t*)(ws + WS_WBM), T, DM, 1024}; pg8::StaticOrder S; S.init(T, DM, G, bx);
        EpiBranchM E{(float*)(ws + WS_T1), (const bf16*)(ws + WS_PROJ)};
        pg8::gemm_phase<EpiBranchM, pg8::StaticOrder, true, true>(lds, g, S, E);
    } SEAM(5);
    if (IN(6)) {
        pg8::Gemm g{(const pg8::bf16_t*)(ws + WS_YG), (const pg8::bf16_t*)(ws + WS_WBG), T, DM, 1024}; pg8::StaticOrder S; S.init(T, DM, G, bx);
        EpiBranchG E{(bf16*)(ws + WS_Z), (const float*)(ws + WS_T1), (const bf16*)(ws + WS_PROJ)};
        pg8::gemm_phase<EpiBranchG, pg8::StaticOrder, true, true>(lds, g, S, E);
    } SEAM(6);
    if (IN(7)) {
        pg8::Gemm g{(const pg8::bf16_t*)(ws + WS_Z), (const pg8::bf16_t*)(ws + WS_WOUT), T, DM, DM}; pg8::StaticOrder S; S.init(T, DM, G, bx);
        EpiMix E{(float*)(ws + WS_PRE), p.x};
        pg8::gemm_phase<EpiMix, pg8::StaticOrder, true, true>(lds, g, S, E);
    } SEAM(7);
    if (IN(8)) { ln_router_phase(p, lds, ctl, G, vcu, wave, lane); } SEAM(8);
    if (IN(9)) { moe_tables(ctl, tst, tid); gather_phase(p, tst, G, vcu, wave, lane); } SEAM(9);
    if (IN(10)) {
        moe_tables(ctl, tst, tid);
        pg8::Gemm g{(const pg8::bf16_t*)(ws + WS_XS), (const pg8::bf16_t*)(ws + WS_WGU), 0, 0, DM}; MoeOrder S{tst, G, bx, 16};
        EpiSwiglu E{(bf16*)(ws + WS_ACT), p.b_gu};
        pg8::gemm_phase<EpiSwiglu, MoeOrder, true, true>(lds, g, S, E);
    } SEAM(10);
    if (IN(11)) {
        moe_tables(ctl, tst, tid);
        pg8::Gemm g{(const pg8::bf16_t*)(ws + WS_ACT), (const pg8::bf16_t*)(ws + WS_WD), 0, 0, DM}; MoeOrder S{tst, G, bx, 8};
        EpiDown E{(bf16*)(ws + WS_OUTS), p.b_down};
        pg8::gemm_phase<EpiDown, MoeOrder, true, true>(lds, g, S, E);
    } SEAM(11);
    if (IN(12)) { moe_tables(ctl, tst, tid); final_phase(p, tst, G, vcu, wave, lane); }
#undef IN
#undef SEAM
}

extern "C" void kernel_launch(void* const* d_in, const int* in_sizes, int n_in, void* d_out, int out_size, void* d_ws, size_t ws_size, hipStream_t stream) {
    static int grid = 0;
    if (grid == 0) {
        if (n_in != 22 || in_sizes[0] != T * DM || out_size != T * DM || ws_size < WS_END) { fprintf(stderr, "kernel_launch: unexpected problem (n_in %d, in0 %d, out %d, ws %zu < %zu); nothing launched\n", n_in, n_in > 0 ? in_sizes[0] : -1, out_size, ws_size, (size_t)WS_END); grid = -1; return; }
        int dev = 0, cus = 0, per_cu = 0;
        if (hipGetDevice(&dev) != hipSuccess || hipDeviceGetAttribute(&cus, hipDeviceAttributeMultiprocessorCount, dev) != hipSuccess) { grid = -1; return; }
        if (hipFuncSetAttribute((const void*)fwd, hipFuncAttributeMaxDynamicSharedMemorySize, LDS_BYTES) != hipSuccess) { fprintf(stderr, "kernel_launch: hipFuncSetAttribute failed\n"); grid = -1; return; }
        if (hipOccupancyMaxActiveBlocksPerMultiprocessor(&per_cu, (const void*)fwd, NTHR, LDS_BYTES) != hipSuccess || per_cu < 1) fprintf(stderr, "kernel_launch: occupancy query reports %d\n", per_cu);
        (void)hipGetLastError();
        grid = cus;
    }
    if (grid < 0) return;
    if (hipMemsetAsync((char*)d_ws + WS_CTL, 0, CTL_ZERO_BYTES, stream) != hipSuccess) return;
    Args a{};
    for (int i = 0; i < 22; ++i) a.in[i] = (const float*)d_in[i];
    a.out = (float*)d_out; a.ws = (unsigned char*)d_ws;
#if MK_ONE_LAUNCH
    a.ph_lo = 0; a.ph_hi = N_PHASES;
    hipLaunchKernelGGL(fwd, dim3(grid), dim3(NTHR), LDS_BYTES, stream, a);
#else
    for (int ph = 0; ph < N_PHASES; ++ph) { a.ph_lo = ph; a.ph_hi = ph + 1; hipLaunchKernelGGL(fwd, dim3(grid), dim3(NTHR), LDS_BYTES, stream, a); }
#endif
}
```

```cpp
#include <hip/hip_runtime.h>
#include <cstdio>
#include <cstdint>
#include <cmath>
namespace pg8 {
#define PG8_LAS __attribute__((address_space(3)))
typedef unsigned short bf16_t;
typedef short bf16x8 __attribute__((ext_vector_type(8)));
typedef float f32x4 __attribute__((ext_vector_type(4)));
typedef unsigned u32x4 __attribute__((ext_vector_type(4)));
constexpr int BM = 256, BK = 64, HALF = 128, HTB = HALF * BK * 2  , STAGE_BYTES = 8 * HTB, NXCD = 8, WGM = 8;

__host__ __device__ __forceinline__ int lds_byte(int r, int c) { const int st = (r >> 4) * 2 + (c >> 5), rr = r & 15, cc = c & 31, ob = rr * 64 + cc * 2; return st * 1024 + (ob ^ (((ob >> 9) & 1) << 5)); }
__host__ __device__ __forceinline__ void stage_rc(int b, int& R, int& C) { const int st = b / 1024, sb = b % 1024, swz = sb ^ (((sb >> 9) & 1) << 5); R = (st >> 1) * 16 + swz / 64; C = (st & 1) * 32 + (swz % 64) / 2; }
__host__ __device__ __forceinline__ int perm32(int rho) { const int n = rho >> 4, i = rho & 15; return 8 * (i >> 2) + 4 * n + (i & 3); }

struct Unit { int pm, pn; };
struct Gemm { const bf16_t* A; const bf16_t* Bt; int M, N, K; };

struct StaticOrder {
    int nM, nN, nwg, G, c;
    __host__ __device__ void init(int M, int N, int G_, int c_) { nM = M / BM; nN = N / BM; nwg = nM * nN; G = G_; c = c_; }
    __host__ __device__ bool next(int i, Unit& u) const {
        const long L = (long)i * G + c; if (L >= nwg) return false;
        int wgid = (int)L; { const int q = nwg / NXCD, r = nwg % NXCD, xcd = wgid % NXCD, off = wgid / NXCD; wgid = (xcd < r ? xcd * (q + 1) : r * (q + 1) + (xcd - r) * q) + off; }
        const int nig = WGM * nN, gid = wgid / nig, fm = gid * WGM, gsz = (nM - fm) < WGM ? (nM - fm) : WGM;
        u.pm = fm + ((wgid % nig) % gsz); u.pn = (wgid % nig) / gsz; return true;
    }
    __device__ __forceinline__ void a_ready(const Unit&) const {}
    __device__ __forceinline__ void done(const Unit&) const {}
};

__device__ __forceinline__ unsigned cvt_pk_bf16(float lo, float hi) { unsigned r; asm volatile("v_cvt_pk_bf16_f32 %0, %1, %2" : "=v"(r) : "v"(lo), "v"(hi)); return r; }
typedef float f32x2 __attribute__((ext_vector_type(2)));
template <class Epi, class Sched, bool ALIGN_EPI = false, bool SP2 = false>
__device__ __forceinline__ void gemm_phase(PG8_LAS unsigned char* lds, const Gemm g, const Sched& S, const Epi& E) {
    const int tid = threadIdx.x, wid = __builtin_amdgcn_readfirstlane(tid >> 6), lane = tid & 63, wr = wid >> 2, wc = wid & 3, fr = lane & 15, fq = lane >> 4;
    const int K = g.K, nt = K / BK;
    unsigned voffA[2], voffB[2];
#pragma unroll
    for (int i = 0; i < 2; ++i) { int R, C; stage_rc(tid * 16 + i * 8192, R, C); const int Rb = Epi::PERM ? ((R & ~31) + perm32(R & 31)) : R;
        voffA[i] = (unsigned)(R * K + C) * 2u; voffB[i] = (unsigned)(Rb * K + C) * 2u; }
    const size_t kstep = (size_t)(BK * 2);
    const size_t hstep = (size_t)HALF * K * 2;
    const size_t tstep = 2 * hstep;
    const unsigned ldsw = (unsigned)wid * 1024u;
    const int aoff = lds_byte(wr * 64 + fr, fq * 8), boff = lds_byte(wc * 32 + fr, fq * 8);
#define PG8_SA(b, h) (((b) * 2 + (h)) * HTB)
#define PG8_SB(b, h) ((4 + (b) * 2 + (h)) * HTB)
#define PG8_STAGE(bufoff, gbase, voff) do { _Pragma("unroll") for (int _i = 0; _i < 2; ++_i) \
        __builtin_amdgcn_global_load_lds((const unsigned*)((const char*)(gbase) + (voff)[_i]), (PG8_LAS unsigned*)(lds + (bufoff) + ldsw + _i * 8192), 16, 0, 0); } while (0)
#define PG8_LDA(dst, b, h) do { _Pragma("unroll") for (int m = 0; m < 4; ++m) _Pragma("unroll") for (int k = 0; k < 2; ++k) dst[m][k] = *(const PG8_LAS bf16x8*)(lds + PG8_SA(b, h) + aoff + m * 2048 + k * 1024); } while (0)
#define PG8_LDB(dst, b, h) do { _Pragma("unroll") for (int n = 0; n < 2; ++n) _Pragma("unroll") for (int k = 0; k < 2; ++k) dst[n][k] = *(const PG8_LAS bf16x8*)(lds + PG8_SB(b, h) + boff + n * 2048 + k * 1024); } while (0)
#define PG8_MMA(ai, bj, At, Bt) do { __builtin_amdgcn_s_setprio(1); _Pragma("unroll") for (int m = 0; m < 4; ++m) _Pragma("unroll") for (int n = 0; n < 2; ++n) _Pragma("unroll") for (int k = 0; k < 2; ++k) \
        acc[ai][bj][m][n] = __builtin_amdgcn_mfma_f32_16x16x32_bf16(Bt[n][k], At[m][k], acc[ai][bj][m][n], 0, 0, 0); __builtin_amdgcn_s_setprio(0); } while (0)
#define PG8_WAIT_V(n) asm volatile("s_waitcnt vmcnt(" #n ")" ::: "memory")
#define PG8_WAIT_L(n) asm volatile("s_waitcnt lgkmcnt(" #n ")" ::: "memory")
#define PG8_BAR __builtin_amdgcn_s_barrier()
#define PG8_SCHED __builtin_amdgcn_sched_barrier(0)
    Unit cur, nxt; int ui = 0;
    if (!S.next(0, cur)) return;
    f32x4 acc[2][2][4][2];
#pragma unroll
    for (int a = 0; a < 2; ++a)
#pragma unroll
        for (int b = 0; b < 2; ++b)
#pragma unroll
            for (int m = 0; m < 4; ++m)
#pragma unroll
                for (int n = 0; n < 2; ++n) acc[a][b][m][n] = (f32x4){0.f, 0.f, 0.f, 0.f};
    bf16x8 At[4][2], B0[2][2], B1[2][2];
    const char* cA = (const char*)g.A + (size_t)cur.pm * tstep; const char* cB = (const char*)g.Bt + (size_t)cur.pn * tstep;
    S.a_ready(cur);
    if constexpr (SP2) {
        PG8_STAGE(PG8_SB(0, 0), cB, voffB); PG8_STAGE(PG8_SB(0, 1), cB + hstep, voffB); PG8_STAGE(PG8_SA(0, 0), cA, voffA); PG8_STAGE(PG8_SA(0, 1), cA + hstep, voffA);
        if (wr == 1) PG8_BAR;
        PG8_WAIT_V(2); PG8_BAR;
        PG8_STAGE(PG8_SB(1, 0), cB + kstep, voffB); PG8_STAGE(PG8_SA(1, 0), cA + kstep, voffA); PG8_STAGE(PG8_SB(1, 1), cB + hstep + kstep, voffB);
        PG8_WAIT_V(6); PG8_BAR;
    } else {
        PG8_STAGE(PG8_SB(0, 0), cB, voffB); PG8_STAGE(PG8_SA(0, 0), cA, voffA); PG8_STAGE(PG8_SB(0, 1), cB + hstep, voffB); PG8_STAGE(PG8_SA(0, 1), cA + hstep, voffA);
        if (wr == 1) PG8_BAR;
        PG8_WAIT_V(4); PG8_BAR;
        PG8_STAGE(PG8_SB(1, 0), cB + kstep, voffB); PG8_STAGE(PG8_SA(1, 0), cA + kstep, voffA); PG8_STAGE(PG8_SB(1, 1), cB + hstep + kstep, voffB);
        PG8_WAIT_V(6); PG8_BAR;
    }
    for (;;) {
        const bool has_next = S.next(ui + 1, nxt);
        const char* nA = has_next ? (const char*)g.A + (size_t)nxt.pm * tstep : cA; const char* nB = has_next ? (const char*)g.Bt + (size_t)nxt.pn * tstep : cB;
        for (int t = 0; t < nt; t += 2) {
            const bool last = (t == nt - 2);
            const char* a1 = cA + (size_t)(t + 1) * kstep;
            const char* a2 = last ? nA : cA + (size_t)(t + 2) * kstep; const char* b2 = last ? nB : cB + (size_t)(t + 2) * kstep;
            const char* a3 = a2 + kstep; const char* b3 = b2 + kstep;
            if (last && has_next) S.a_ready(nxt);
            if constexpr (SP2) {
            PG8_LDB(B0, 0, 0); PG8_LDB(B1, 0, 1); PG8_SCHED; PG8_LDA(At, 0, 0); PG8_STAGE(PG8_SA(1, 1), a1 + hstep, voffA);
            PG8_WAIT_V(8); PG8_WAIT_L(0); PG8_BAR; PG8_MMA(0, 0, At, B0); PG8_MMA(0, 1, At, B1); PG8_BAR; PG8_SCHED;
            PG8_LDA(At, 0, 1); PG8_STAGE(PG8_SB(0, 0), b2, voffB); PG8_STAGE(PG8_SB(0, 1), b2 + hstep, voffB); PG8_STAGE(PG8_SA(0, 0), a2, voffA);
            PG8_WAIT_V(8); PG8_WAIT_L(0); PG8_BAR; PG8_MMA(1, 0, At, B0); PG8_MMA(1, 1, At, B1); PG8_BAR; PG8_SCHED;
            PG8_LDB(B0, 1, 0); PG8_LDB(B1, 1, 1); PG8_SCHED; PG8_LDA(At, 1, 0); PG8_STAGE(PG8_SA(0, 1), a2 + hstep, voffA);
            PG8_WAIT_V(8); PG8_WAIT_L(0); PG8_BAR; PG8_MMA(0, 0, At, B0); PG8_MMA(0, 1, At, B1); PG8_BAR; PG8_SCHED;
            PG8_LDA(At, 1, 1); PG8_STAGE(PG8_SB(1, 0), b3, voffB); PG8_STAGE(PG8_SB(1, 1), b3 + hstep, voffB); PG8_STAGE(PG8_SA(1, 0), a3, voffA);
            PG8_WAIT_V(8); PG8_WAIT_L(0); PG8_BAR; PG8_MMA(1, 0, At, B0); PG8_MMA(1, 1, At, B1); PG8_BAR; PG8_SCHED;
            } else {
            PG8_LDB(B0, 0, 0); PG8_SCHED; PG8_LDA(At, 0, 0); PG8_STAGE(PG8_SA(1, 1), a1 + hstep, voffA);
            PG8_WAIT_L(8); PG8_BAR; PG8_WAIT_L(0); PG8_MMA(0, 0, At, B0); PG8_BAR; PG8_SCHED;
            PG8_LDB(B1, 0, 1); PG8_STAGE(PG8_SB(0, 0), b2, voffB);
            PG8_BAR; PG8_WAIT_L(0); PG8_MMA(0, 1, At, B1); PG8_BAR;
            PG8_LDA(At, 0, 1); PG8_STAGE(PG8_SA(0, 0), a2, voffA);
            PG8_BAR; PG8_WAIT_L(0); PG8_MMA(1, 0, At, B0); PG8_BAR; PG8_SCHED;
            PG8_STAGE(PG8_SB(0, 1), b2 + hstep, voffB);
            PG8_WAIT_V(6); PG8_BAR; PG8_MMA(1, 1, At, B1); PG8_BAR;
            PG8_LDB(B0, 1, 0); PG8_SCHED; PG8_LDA(At, 1, 0); PG8_STAGE(PG8_SA(0, 1), a2 + hstep, voffA);
            PG8_WAIT_L(8); PG8_BAR; PG8_WAIT_L(0); PG8_MMA(0, 0, At, B0); PG8_BAR; PG8_SCHED;
            PG8_LDB(B1, 1, 1); PG8_STAGE(PG8_SB(1, 0), b3, voffB);
            PG8_BAR; PG8_WAIT_L(0); PG8_MMA(0, 1, At, B1); PG8_BAR;
            PG8_LDA(At, 1, 1); PG8_STAGE(PG8_SA(1, 0), a3, voffA);
            PG8_BAR; PG8_WAIT_L(0); PG8_MMA(1, 0, At, B0); PG8_BAR; PG8_SCHED;
            PG8_STAGE(PG8_SB(1, 1), b3 + hstep, voffB);
            PG8_WAIT_V(6); PG8_BAR; PG8_MMA(1, 1, At, B1); PG8_BAR;
            }
        }
        if constexpr (ALIGN_EPI) { if (wr == 0) PG8_BAR; }
        bool keep_acc = false;
        if constexpr (Epi::CHAIN) { keep_acc = E.chain(acc, cur, wr, wc, fr, fq); S.done(cur); }
        else if constexpr (!Epi::AFTER_DRAIN) { E(acc, cur, wr, wc, fr, fq); S.done(cur); }
        if (!has_next) break;
        if (!keep_acc)
#pragma unroll
        for (int a = 0; a < 2; ++a)
#pragma unroll
            for (int b = 0; b < 2; ++b)
#pragma unroll
                for (int m = 0; m < 4; ++m)
#pragma unroll
                    for (int n = 0; n < 2; ++n) acc[a][b][m][n] = (f32x4){0.f, 0.f, 0.f, 0.f};
        cur = nxt; cA = nA; cB = nB; ++ui;
        if constexpr (ALIGN_EPI) { if (wr == 1) PG8_BAR; }
    }
    PG8_WAIT_V(0);
    if constexpr (!ALIGN_EPI) { if (wr == 0) PG8_BAR; }
    PG8_BAR;
    if constexpr (Epi::AFTER_DRAIN) { E.fused(acc, cur, wr, wc, fr, fq, lds, wid, lane); S.done(cur); }
#undef PG8_SA
#undef PG8_SB
#undef PG8_STAGE
#undef PG8_LDA
#undef PG8_LDB
#undef PG8_MMA
#undef PG8_WAIT_V
#undef PG8_WAIT_L
#undef PG8_BAR
#undef PG8_SCHED
}
}
namespace pg8 {
typedef int i32x4v __attribute__((ext_vector_type(4)));
typedef int i32x8v __attribute__((ext_vector_type(8)));
struct Gemm8 { const unsigned char* A; const unsigned char* Bt; int K; };
template <class Epi, class Sched>
__device__ __forceinline__ void gemm_phase_f8(PG8_LAS unsigned char* lds, const Gemm8 g, const Sched& S, const Epi& E) {
    const int tid = threadIdx.x, wid = __builtin_amdgcn_readfirstlane(tid >> 6), lane = tid & 63, wr = wid >> 2, wc = wid & 3, fr = lane & 15, fq = lane >> 4;
    const int K = g.K, nt = K / 128;
    unsigned voffB[2];
#pragma unroll
    for (int i = 0; i < 2; ++i) { int R, C; stage_rc(tid * 16 + i * 8192, R, C); const int Rb = Epi::PERM ? ((R & ~31) + perm32(R & 31)) : R;
        voffB[i] = (unsigned)(Rb * K + C * 2); }
    PG8_LAS u32x4* nxslot = (PG8_LAS u32x4*)(lds + 133120) + tid;
    const size_t kstep = 128;
    const size_t hstep = (size_t)HALF * K;
    const size_t tstep = 2 * hstep;
    const unsigned ldsw = (unsigned)wid * 1024u;
    const int aoff = lds_byte(wr * 64 + fr, fq * 16), boff = lds_byte(wc * 32 + fr, fq * 16);
#define F8_SA(b, h) (((b) * 2 + (h)) * HTB)
#define F8_SB(b, h) ((4 + (b) * 2 + (h)) * HTB)
#define F8_STAGE(bufoff, gbase, voff) do { _Pragma("unroll") for (int _i = 0; _i < 2; ++_i) \
        __builtin_amdgcn_global_load_lds((const unsigned*)((const char*)(gbase) + (voff)[_i]), (PG8_LAS unsigned*)(lds + (bufoff) + ldsw + _i * 8192), 16, 0, 0); } while (0)
#define F8_LD(dst, off) do { const i32x4v _lo = *(const PG8_LAS i32x4v*)(lds + (off)), _hi = *(const PG8_LAS i32x4v*)(lds + (off) + 16); dst = __builtin_shufflevector(_lo, _hi, 0, 1, 2, 3, 4, 5, 6, 7); } while (0)
#define F8_LDA(dst, b, h) do { _Pragma("unroll") for (int m = 0; m < 4; ++m) F8_LD(dst[m], F8_SA(b, h) + aoff + m * 2048); } while (0)
#define F8_LDB(dst, b, h) do { _Pragma("unroll") for (int n = 0; n < 2; ++n) F8_LD(dst[n], F8_SB(b, h) + boff + n * 2048); } while (0)
#define F8_MMA(ai, bj, At, Bt) do { __builtin_amdgcn_s_setprio(1); _Pragma("unroll") for (int m = 0; m < 4; ++m) _Pragma("unroll") for (int n = 0; n < 2; ++n) \
        acc[ai][bj][m][n] = __builtin_amdgcn_mfma_scale_f32_16x16x128_f8f6f4(Bt[n], At[m], acc[ai][bj][m][n], 0, 0, 0, 0, 0, 0); __builtin_amdgcn_s_setprio(0); } while (0)
#define F8_WAIT_V(n) asm volatile("s_waitcnt vmcnt(" #n ")" ::: "memory")
#define F8_WAIT_L(n) asm volatile("s_waitcnt lgkmcnt(" #n ")" ::: "memory")
#define F8_BAR __builtin_amdgcn_s_barrier()
#define F8_SCHED __builtin_amdgcn_sched_barrier(0)
#define F8_ROWS(dst, u) do { int _tz = threadIdx.x; asm volatile("" : "+v"(_tz)); _Pragma("unroll") for (int _i = 0; _i < 2; ++_i) { int _R, _C; stage_rc(_tz * 16 + _i * 8192, _R, _C); \
        _Pragma("unroll") for (int _h = 0; _h < 2; ++_h) dst[_h][_i] = S.a_row(u, _h * 128 + _R) * (unsigned)K + (unsigned)(_C * 2); } } while (0)
    Unit cur, nxt; int ui = 0;
    if (!S.next(0, cur)) return;
    f32x4 acc[2][2][4][2];
#pragma unroll
    for (int a = 0; a < 2; ++a)
#pragma unroll
        for (int b = 0; b < 2; ++b)
#pragma unroll
            for (int m = 0; m < 4; ++m)
#pragma unroll
                for (int n = 0; n < 2; ++n) acc[a][b][m][n] = (f32x4){0.f, 0.f, 0.f, 0.f};
    i32x8v At[4], B0[2], B1[2];
    unsigned curA[2][2];
    F8_ROWS(curA, cur);
    const char* gA = (const char*)g.A;
    const char* cB = (const char*)g.Bt + (size_t)cur.pn * tstep;
    S.a_ready(cur);
    F8_STAGE(F8_SB(0, 0), cB, voffB); F8_STAGE(F8_SB(0, 1), cB + hstep, voffB); F8_STAGE(F8_SA(0, 0), gA, curA[0]); F8_STAGE(F8_SA(0, 1), gA, curA[1]);
    if (wr == 1) F8_BAR;
    F8_WAIT_V(2); F8_BAR;
    F8_STAGE(F8_SB(1, 0), cB + kstep, voffB); F8_STAGE(F8_SA(1, 0), gA + kstep, curA[0]); F8_STAGE(F8_SB(1, 1), cB + hstep + kstep, voffB);
    F8_WAIT_V(6); F8_BAR;
    for (;;) {
        const bool has_next = S.next(ui + 1, nxt);
        { unsigned nx[2][2];
          if (has_next) { F8_ROWS(nx, nxt); } else { nx[0][0] = curA[0][0]; nx[0][1] = curA[0][1]; nx[1][0] = curA[1][0]; nx[1][1] = curA[1][1]; }
          *nxslot = (u32x4){nx[0][0], nx[0][1], nx[1][0], nx[1][1]}; }
        const char* nB = has_next ? (const char*)g.Bt + (size_t)nxt.pn * tstep : cB;
        for (int t = 0; t < nt; t += 2) {
            const bool last = (t == nt - 2);
            const char* a1 = gA + (size_t)(t + 1) * kstep;
            const char* a2 = last ? gA : gA + (size_t)(t + 2) * kstep; const char* b2 = last ? nB : cB + (size_t)(t + 2) * kstep;
            const char* a3 = a2 + kstep; const char* b3 = b2 + kstep;
            if (last && has_next) S.a_ready(nxt);
            F8_LDB(B0, 0, 0); F8_LDB(B1, 0, 1); F8_SCHED; F8_LDA(At, 0, 0); F8_STAGE(F8_SA(1, 1), a1, curA[1]);
            if (last) { const u32x4 nv = *nxslot; curA[0][0] = nv.x; curA[0][1] = nv.y; curA[1][0] = nv.z; curA[1][1] = nv.w; }
            F8_WAIT_V(8); F8_WAIT_L(0); F8_BAR; F8_MMA(0, 0, At, B0); F8_MMA(0, 1, At, B1); F8_BAR; F8_SCHED;
            F8_LDA(At, 0, 1); F8_STAGE(F8_SB(0, 0), b2, voffB); F8_STAGE(F8_SB(0, 1), b2 + hstep, voffB); F8_STAGE(F8_SA(0, 0), a2, curA[0]);
            F8_WAIT_V(8); F8_WAIT_L(0); F8_BAR; F8_MMA(1, 0, At, B0); F8_MMA(1, 1, At, B1); F8_BAR; F8_SCHED;
            F8_LDB(B0, 1, 0); F8_LDB(B1, 1, 1); F8_SCHED; F8_LDA(At, 1, 0); F8_STAGE(F8_SA(0, 1), a2, curA[1]);
            F8_WAIT_V(8); F8_WAIT_L(0); F8_BAR; F8_MMA(0, 0, At, B0); F8_MMA(0, 1, At, B1); F8_BAR; F8_SCHED;
            F8_LDA(At, 1, 1); F8_STAGE(F8_SB(1, 0), b3, voffB); F8_STAGE(F8_SB(1, 1), b3 + hstep, voffB); F8_STAGE(F8_SA(1, 0), a3, curA[0]);
            F8_WAIT_V(8); F8_WAIT_L(0); F8_BAR; F8_MMA(1, 0, At, B0); F8_MMA(1, 1, At, B1); F8_BAR; F8_SCHED;
        }
        if (wr == 0) F8_BAR;
        E(acc, cur, wr, wc, fr, fq); S.done(cur);
        if (!has_next) break;
#pragma unroll
        for (int a = 0; a < 2; ++a)
#pragma unroll
            for (int b = 0; b < 2; ++b)
#pragma unroll
                for (int m = 0; m < 4; ++m)
#pragma unroll
                    for (int n = 0; n < 2; ++n) acc[a][b][m][n] = (f32x4){0.f, 0.f, 0.f, 0.f};
        cur = nxt; cB = nB; ++ui;
        if (wr == 1) F8_BAR;
    }
    F8_WAIT_V(0);
    F8_BAR;
#undef F8_SA
#undef F8_SB
#undef F8_STAGE
#undef F8_LD
#undef F8_LDA
#undef F8_LDB
#undef F8_MMA
#undef F8_WAIT_V
#undef F8_WAIT_L
#undef F8_BAR
#undef F8_SCHED
#undef F8_ROWS
}
}
#define GAS __attribute__((address_space(1)))
#define LAS __attribute__((address_space(3)))
typedef unsigned short bf16;
typedef unsigned v4u __attribute__((ext_vector_type(4)));
typedef float f32x4 __attribute__((ext_vector_type(4)));
typedef short bf16x8 __attribute__((ext_vector_type(8)));
typedef GAS unsigned gu32;
typedef GAS unsigned long long gu64;
#define RLX_AGENT __ATOMIC_RELAXED, __HIP_MEMORY_SCOPE_AGENT
#define LDS_WAIT() asm volatile("s_waitcnt lgkmcnt(0)" ::: "memory")
#define VM_WAIT() asm volatile("s_waitcnt vmcnt(0)" ::: "memory")
__device__ __forceinline__ unsigned long long rt() { return __builtin_amdgcn_s_memrealtime(); }
__device__ __forceinline__ unsigned f2bf(float f) { unsigned u = __builtin_bit_cast(unsigned, f); return (u + 0x7fffu + ((u >> 16) & 1u)) >> 16; }
__device__ __forceinline__ unsigned pk2(float lo, float hi) { return f2bf(lo) | (f2bf(hi) << 16); }

#define XB_TMO      128
#define XB_XCNT(j)  (256  + 64 * (j))
#define XB_XSUB(j)  (1280 + 64 * (j))
#define XB_XGEN(j)  (2304 + 64 * (j))
#define XB_TOP      3328
#define XB_TOPGEN   3392
#define XCD_BAR_WORDS 3456
#define XB_SPIN_CAP (1u << 18)

__device__ __forceinline__ unsigned xb_ld(unsigned* p)              { return __hip_atomic_load(p, __ATOMIC_RELAXED, __HIP_MEMORY_SCOPE_AGENT); }
__device__ __forceinline__ unsigned xb_add(unsigned* p, unsigned v) { return __hip_atomic_fetch_add(p, v, __ATOMIC_RELAXED, __HIP_MEMORY_SCOPE_AGENT); }
__device__ __forceinline__ unsigned xb_xcc_id() { return (unsigned)__builtin_amdgcn_s_getreg((3 << 11) | 20) & 0xFu; }
#define XB_SPIN(cond, bar) do { unsigned _sp = 0; while (cond) { __builtin_amdgcn_s_sleep(1); \
    if ((++_sp & 255u) == 0u) { if (xb_ld(&(bar)[XB_TMO])) break; if (_sp > XB_SPIN_CAP) { atomicAdd(&(bar)[XB_TMO], 1u); break; } } } } while (0)

struct XcdBarrier {
    unsigned* bar; unsigned x;
    volatile LAS unsigned* st;
};

__device__ __forceinline__ XcdBarrier xcd_barrier_post(unsigned* bar, volatile LAS unsigned* st) {
    XcdBarrier b; b.bar = bar; b.x = xb_xcc_id(); b.st = st;
    if (threadIdx.x == 0) (void)xb_add(&bar[XB_XCNT(b.x)], 1u);
    return b;
}
__device__ __forceinline__ void xcd_barrier_complete(unsigned* bar, unsigned x, unsigned& nloc, unsigned& nx) {
    const unsigned G = gridDim.x * gridDim.y * gridDim.z;
    unsigned sum, cnt, mine, sp = 0u;
    for (;;) {
        sum = 0u; cnt = 0u; mine = 0u;
#pragma unroll
        for (unsigned j = 0; j < 16; ++j) { const unsigned c = xb_ld(&bar[XB_XCNT(j)]); sum += c; cnt += (c > 0u) ? 1u : 0u; mine = (j == x) ? c : mine; }
        if (sum == G) break;
        __builtin_amdgcn_s_sleep(1);
        if ((++sp & 255u) == 0u) { if (xb_ld(&bar[XB_TMO])) break; if (sp > XB_SPIN_CAP) { atomicAdd(&bar[XB_TMO], 1u); break; } }
    }
    nloc = mine > 0u ? mine : 1u; nx = cnt > 0u ? cnt : 1u;
}

__device__ __forceinline__ void xcd_barrier(const XcdBarrier& b) {
    asm volatile("s_waitcnt vmcnt(0)" ::: "memory");
    __syncthreads();
    if (threadIdx.x == 0) {
        unsigned* bar = b.bar;
        __builtin_amdgcn_s_waitcnt(0);
        unsigned nloc = b.st[0], nx = b.st[1];
        if (nloc == 0u) { xcd_barrier_complete(bar, b.x, nloc, nx); b.st[0] = nloc; b.st[1] = nx; }
        const unsigned old = xb_add(&bar[XB_XSUB(b.x)], 1u);
        const unsigned gen = old / nloc;
        if (old + 1u == (gen + 1u) * nloc) {
            __builtin_amdgcn_fence(__ATOMIC_RELEASE, "agent");
            asm volatile("s_waitcnt vmcnt(0)" ::: "memory");
            const unsigned og = xb_add(&bar[XB_TOP], 1u);
            const unsigned tg = og / nx;
            if (og + 1u == (tg + 1u) * nx) xb_add(&bar[XB_TOPGEN], 1u);
            else XB_SPIN(xb_ld(&bar[XB_TOPGEN]) == tg, bar);
            __builtin_amdgcn_fence(__ATOMIC_ACQUIRE, "agent");
            xb_add(&bar[XB_XGEN(b.x)], 1u);
            asm volatile("s_waitcnt vmcnt(0)" ::: "memory");
        } else {
            XB_SPIN(xb_ld(&bar[XB_XGEN(b.x)]) == gen, bar);
            __builtin_amdgcn_fence(__ATOMIC_ACQUIRE, "agent");
            asm volatile("s_waitcnt vmcnt(0)" ::: "memory");
        }
    }
    __syncthreads();
}

constexpr int NWAVES = 8, NTHR = NWAVES * 64;
constexpr int BATCH = 8, SEQ = 4096, DM = 2048, T = BATCH * SEQ;
constexpr int NH = 4, DK = 128, DV = 256, CH = 64, NC = SEQ / CH, NBH = BATCH * NH, NCHUNK = NBH * NC;
constexpr int D_IN = 10264, NP1 = 10496, NPROJ = 10240;
constexpr int NE = 32, TOPK = 4, DFF = 2048;
constexpr int P_MAX = T * TOPK + NE * 256;
constexpr float LN_EPS = 1e-5f;
constexpr float DN_ALPHA = 1.18920711500272f;
constexpr float RSQRT_DK = 0.08838834764831845f;
constexpr float X8_SCALE = 16.f, W8_SCALE = 512.f, A8_SCALE = 8.f, O8_SCALE = 64.f;
constexpr int PC_MQ = 0, PC_MK = 512, PC_MV = 1024, PC_MO = 2048, PC_GQ = 3072, PC_GK = 3584, PC_GV = 4096, PC_GG = 5120, PC_GATEM = 6144, PC_GATEG = 8192;

constexpr size_t MiB = 1u << 20;
constexpr size_t WS_CTL = 0, CTL_ZERO_BYTES = 128 * 1024;
constexpr size_t WS_BIAS1 = 1 * MiB, WS_WRT = 1 * MiB + 65536;
constexpr size_t WS_WIN = 2 * MiB, WS_WBM = 44 * MiB, WS_WBG = 48 * MiB, WS_WOUT = 52 * MiB, WS_WGU = 64 * MiB, WS_WD = 576 * MiB;
constexpr size_t WS_XB = 832 * MiB, WS_PROJ = 960 * MiB, WS_SMALL = 1600 * MiB;
constexpr size_t WS_MSTATE = 1608 * MiB, WS_GSTATE = 1868 * MiB, WS_MPREV = 2124 * MiB, WS_GPREV = 2252 * MiB, WS_MISC = 2380 * MiB;
constexpr size_t WS_YM = 2384 * MiB, WS_YG = 2448 * MiB, WS_T1 = 2512 * MiB, WS_Z = 2768 * MiB, WS_PRE = 2896 * MiB, WS_X1 = 3152 * MiB, WS_X1B = 3408 * MiB, WS_X1F8 = 3408 * MiB;
constexpr size_t WS_XS = 960 * MiB, WS_ACT = 1504 * MiB, WS_OUTS = 2048 * MiB;
constexpr size_t WS_WIN8 = 320 * MiB;
constexpr size_t WS_XB8 = 3408 * MiB;
constexpr size_t WS_GATES = 1736 * MiB;
constexpr size_t WS_QC = WS_T1, WS_KC = WS_T1 + 32 * MiB, WS_QI = WS_T1 + 64 * MiB, WS_KI = WS_T1 + 96 * MiB;
constexpr size_t WS_SLOT = 3536 * MiB, WS_ASG = 3540 * MiB, WS_END = 3544 * MiB;
static_assert(WS_WIN + (size_t)NP1 * DM * 2 <= WS_WBM && WS_WGU + (size_t)NE * 4096 * DM * 2 <= WS_WD && WS_WD + (size_t)NE * DM * DM * 2 <= WS_XB, "ws map 1");
static_assert(WS_PROJ + (size_t)T * NPROJ * 2 <= WS_SMALL && WS_MSTATE + (size_t)NCHUNK * 257 * 128 * 4 <= WS_GSTATE && WS_GSTATE + (size_t)NCHUNK * 256 * 128 * 4 <= WS_MPREV, "ws map 2");
static_assert(WS_MSTATE + (size_t)NCHUNK * 32768 * 2 <= WS_GATES && WS_GATES + (size_t)T * 4096 <= WS_GSTATE, "gates span");
static_assert(WS_XS + (size_t)P_MAX * DM * 2 <= WS_ACT && WS_ACT + (size_t)P_MAX * DM * 2 <= WS_OUTS && WS_OUTS + (size_t)P_MAX * DM * 2 <= WS_Z, "ws map 3");
constexpr size_t MISC_NPREV = 0, MISC_MPREV = 1 * MiB, MISC_GEND = 1 * MiB + 65536, MISC_BEND = 1 * MiB + 131072, MISC_GDEC = 2 * MiB, MISC_DN = 3 * MiB;
constexpr int CW_BAR = 4096;
constexpr int CW_CNT = 16384;

constexpr int RING_BYTES = 131072;
constexpr int LDSCTL_OFF = RING_BYTES, MISC_OFF = LDSCTL_OFF + 320;
constexpr int TST_OFF = LDSCTL_OFF + 1024;
constexpr int LDS_BYTES = 147456;

__device__ __forceinline__ float bf2f(unsigned b) { return __builtin_bit_cast(float, b << 16); }
typedef _Float16 f16x2 __attribute__((ext_vector_type(2)));
typedef _Float16 f16x8 __attribute__((ext_vector_type(8)));
__device__ __forceinline__ unsigned pkh2(float lo, float hi) { const f16x2 h = {(_Float16)lo, (_Float16)hi}; return __builtin_bit_cast(unsigned, h); }
__device__ __forceinline__ float wave_sum(float v) {
#pragma unroll
    for (int o = 1; o < 64; o <<= 1) v += __shfl_xor(v, o);
    return v;
}
__device__ __forceinline__ float wave_max(float v) {
#pragma unroll
    for (int o = 1; o < 64; o <<= 1) v = fmaxf(v, __shfl_xor(v, o));
    return v;
}
__device__ __forceinline__ float logsigmoidf(float x) { return fminf(x, 0.f) - log1pf(expf(-fabsf(x))); }
__device__ __forceinline__ float sigmoid_fast(float x) { return __builtin_amdgcn_rcpf(1.f + __builtin_amdgcn_exp2f(x * -1.4426950408889634f)); }
__device__ __forceinline__ unsigned pk4_u8(float a, float b, float c, float d) {
    const unsigned ua = (unsigned)(a * 255.f + 0.5f), ub = (unsigned)(b * 255.f + 0.5f), uc = (unsigned)(c * 255.f + 0.5f), ud = (unsigned)(d * 255.f + 0.5f);
    return ua | (ub << 8) | (uc << 16) | (ud << 24); }
__device__ __forceinline__ void unpack8_u8(unsigned long long w, float (&o)[8]) {
    const unsigned lo = (unsigned)w, hi = (unsigned)(w >> 32);
    o[0] = (float)(lo & 0xffu); o[1] = (float)((lo >> 8) & 0xffu); o[2] = (float)((lo >> 16) & 0xffu); o[3] = (float)(lo >> 24);
    o[4] = (float)(hi & 0xffu); o[5] = (float)((hi >> 8) & 0xffu); o[6] = (float)((hi >> 16) & 0xffu); o[7] = (float)(hi >> 24); }
__device__ __forceinline__ float logsigmoid_fast(float x) { return fminf(x, 0.f) - __logf(1.f + __expf(-fabsf(x))); }
__device__ __forceinline__ void unpack8(const v4u r, float (&o)[8]) {
    o[0] = bf2f(r.x & 0xffffu); o[1] = bf2f(r.x >> 16); o[2] = bf2f(r.y & 0xffffu); o[3] = bf2f(r.y >> 16);
    o[4] = bf2f(r.z & 0xffffu); o[5] = bf2f(r.z >> 16); o[6] = bf2f(r.w & 0xffffu); o[7] = bf2f(r.w >> 16);
}

struct KP {
    const float *x, *w_in, *b_in, *conv_w, *conv_b, *w_gla, *b_gla, *m_norm_w, *g_norm_w, *w_bm, *w_bg, *w_out, *ln1_g, *ln1_b, *w_router, *b_router, *w_gu, *b_gu, *w_down, *b_down, *ln2_g, *ln2_b;
    float* out; unsigned char* ws;
};

#ifndef F8_GEMM1_MODE
#define F8_GEMM1_MODE 2
#endif
__host__ __device__ __forceinline__ bool f8_col_tile(int pn) { return F8_GEMM1_MODE == 0 ? false : (pn >= 24 && pn < 40) || (F8_GEMM1_MODE >= 2 && pn >= 8 && pn < 12) || (F8_GEMM1_MODE == 3 && ((pn >= 4 && pn < 8) || (pn >= 16 && pn < 20))); }
constexpr int N_F8_TILES = F8_GEMM1_MODE == 0 ? 0 : (F8_GEMM1_MODE == 3 ? 28 : (F8_GEMM1_MODE == 2 ? 20 : 16)), N_BF_TILES = 41 - N_F8_TILES;
__host__ __device__ __forceinline__ int bf_tile(int i) { return F8_GEMM1_MODE == 3 ? (i < 4 ? i : (i < 8 ? i + 8 : (i < 12 ? i + 12 : 40))) : F8_GEMM1_MODE == 2 ? (i < 8 ? i : (i < 20 ? i + 4 : 40)) : (F8_GEMM1_MODE == 1 ? (i < 24 ? i : 40) : i); }
__host__ __device__ __forceinline__ int f8_tile(int i) { return F8_GEMM1_MODE == 3 ? (i < 8 ? 4 + i : (i < 12 ? 8 + i : 12 + i)) : F8_GEMM1_MODE == 2 ? (i < 4 ? 8 + i : 20 + i) : 24 + i; }
__device__ __forceinline__ unsigned pk4_fp8(float a, float b, float c, float d) {
    a = fminf(fmaxf(a, -448.f), 448.f); b = fminf(fmaxf(b, -448.f), 448.f); c = fminf(fmaxf(c, -448.f), 448.f); d = fminf(fmaxf(d, -448.f), 448.f);
    int w = 0; w = __builtin_amdgcn_cvt_pk_fp8_f32(a, b, w, false); w = __builtin_amdgcn_cvt_pk_fp8_f32(c, d, w, true); return (unsigned)w; }
struct CvItem { const GAS float* src; unsigned char* dst; int ldw; };
__device__ __forceinline__ void cv_load(f32x4 (&v)[4][4], const CvItem& it) {
#pragma unroll
    for (int a = 0; a < 4; ++a)
#pragma unroll
        for (int b = 0; b < 4; ++b) v[a][b] = *(const GAS f32x4*)(it.src + (size_t)(32 * a + b) * it.ldw);
}
__device__ __forceinline__ void cv_finish(const f32x4 (&v)[4][4], const CvItem& it, int K, float sc, LAS unsigned* scr, int lane) {
    const int kr = lane >> 3, ng = lane & 7;
#pragma unroll
    for (int a = 0; a < 4; ++a)
#pragma unroll
        for (int j = 0; j < 4; ++j) scr[(4 * ng + j) * 33 + 8 * a + kr] = pk4_fp8(v[a][0][j] * sc, v[a][1][j] * sc, v[a][2][j] * sc, v[a][3][j] * sc);
    LDS_WAIT(); asm volatile("" ::: "memory");
    const int ch = lane & 7;
#pragma unroll
    for (int ps = 0; ps < 4; ++ps) { const int row = (lane >> 3) + 8 * ps; const LAS unsigned* s = scr + row * 33 + 4 * ch;
        v4u o; o.x = s[0]; o.y = s[1]; o.z = s[2]; o.w = s[3];
        *(GAS v4u*)(it.dst + (size_t)row * K + 16 * ch) = o; }
    LDS_WAIT(); asm volatile("" ::: "memory");
}
template <class F> __device__ __forceinline__ void transpose_item16w(const float* W, int K, int ldw, bf16* WT, unsigned char* WT8, float sc8, int n0, int k0, F srccol, LAS unsigned* scr, int lane) {
    const int kr = lane >> 3, ng = lane & 7; const int scol = srccol(n0 + 4 * ng);
    const GAS float* src = (const GAS float*)(W + (size_t)(k0 + 2 * kr) * ldw + (scol >= 0 ? scol : 0));
    f32x4 v[4][2];
#pragma unroll
    for (int a = 0; a < 4; ++a)
#pragma unroll
        for (int b = 0; b < 2; ++b) { v[a][b] = *(const GAS f32x4*)(src + (size_t)(16 * a + b) * ldw); if (scol < 0) v[a][b] = (f32x4){0.f, 0.f, 0.f, 0.f}; }
#pragma unroll
    for (int a = 0; a < 4; ++a)
#pragma unroll
        for (int j = 0; j < 4; ++j) scr[(4 * ng + j) * 33 + 8 * a + kr] = pk2(v[a][0][j], v[a][1][j]);
    LAS unsigned* scr8 = scr + 32 * 33;
    if (WT8) {
#pragma unroll
        for (int a = 0; a < 4; ++a)
#pragma unroll
            for (int j = 0; j < 4; ++j) { int w = 0; w = __builtin_amdgcn_cvt_pk_fp8_f32(fminf(fmaxf(v[a][0][j] * sc8, -448.f), 448.f), fminf(fmaxf(v[a][1][j] * sc8, -448.f), 448.f), w, false);
                ((LAS unsigned short*)scr8)[(4 * ng + j) * 34 * 2 + 8 * a + kr] = (unsigned short)w; }
    }
    LDS_WAIT(); asm volatile("" ::: "memory");
    const int ch = lane & 7;
#pragma unroll
    for (int ps = 0; ps < 4; ++ps) { const int row = (lane >> 3) + 8 * ps; const LAS unsigned* s = scr + row * 33 + 4 * ch;
        v4u o; o.x = s[0]; o.y = s[1]; o.z = s[2]; o.w = s[3];
        *(GAS v4u*)(WT + (size_t)(n0 + row) * K + k0 + 8 * ch) = o; }
    if (WT8) {
#pragma unroll
        for (int ps = 0; ps < 2; ++ps) { const int row = (lane >> 2) + 16 * ps, c4 = lane & 3; const LAS unsigned* s = scr8 + row * 34 + 4 * c4;
            v4u o; o.x = s[0]; o.y = s[1]; o.z = s[2]; o.w = s[3];
            *(GAS v4u*)(WT8 + (size_t)(n0 + row) * K + k0 + 16 * c4) = o; }
    }
    LDS_WAIT(); asm volatile("" ::: "memory");
}
struct ColIdent { __device__ __forceinline__ int operator()(int n) const { return n; } };
struct ColWin { __device__ __forceinline__ int operator()(int n) const {
    if (n < 3072) return n; if (n < 6144) return n + 8; if (n < 10240) return n + 24;
    const int j = n - 10240; if (j < 8) return 3072 + j; if (j < 24) return 6152 + (j - 8); return -1; } };
struct ColGu { __device__ __forceinline__ int operator()(int n) const { const int jt = n >> 8, w = n & 255; return w < 128 ? 128 * jt + w : 2048 + 128 * jt + (w - 128); } };

__device__ __forceinline__ void p0_prologue(const KP& p, LAS unsigned char* lds, int G, int vcu, int wave, int lane) {
    LAS float* scr = (LAS float*)(lds + wave * 16384);
    const int gw = vcu * NWAVES + wave, NGW = G * NWAVES;
    unsigned char* ws = p.ws;
    bf16* WIN = (bf16*)(ws + WS_WIN); bf16* WBM = (bf16*)(ws + WS_WBM); bf16* WBG = (bf16*)(ws + WS_WBG); bf16* WOUT = (bf16*)(ws + WS_WOUT);
    constexpr int I_IN = 32 * (NP1 / 32), I_BM = 16 * 64, I_OUT = 32 * 64;
    constexpr int NITEMS = I_IN + 2 * I_BM + I_OUT;
    for (int it = gw; it < NITEMS; it += NGW) {
        int r = it;
        LAS unsigned* scu = (LAS unsigned*)scr;
        if (r < I_IN) { const int nblk = NP1 / 32; transpose_item16w(p.w_in, DM, D_IN, WIN, f8_col_tile((r % nblk) >> 3) ? ws + WS_WIN8 : (unsigned char*)nullptr, W8_SCALE, 32 * (r % nblk), 64 * (r / nblk), ColWin(), scu, lane); continue; } r -= I_IN;
        if (r < I_BM) { transpose_item16w(p.w_bm, 1024, DM, WBM, (unsigned char*)nullptr, 0.f, 32 * (r % 64), 64 * (r / 64), ColIdent(), scu, lane); continue; } r -= I_BM;
        if (r < I_BM) { transpose_item16w(p.w_bg, 1024, DM, WBG, (unsigned char*)nullptr, 0.f, 32 * (r % 64), 64 * (r / 64), ColIdent(), scu, lane); continue; } r -= I_BM;
        { transpose_item16w(p.w_out, DM, DM, WOUT, (unsigned char*)nullptr, 0.f, 32 * (r % 64), 64 * (r / 64), ColIdent(), scu, lane); }
    }
    bf16* XB = (bf16*)(ws + WS_XB);
    for (int m = gw; m < T; m += 2 * NGW) {
        const int m2 = m + NGW; const bool has2 = m2 < T;
        f32x4 va[8], vb[8];
#pragma unroll
        for (int j = 0; j < 8; ++j) { va[j] = ((const GAS f32x4*)(p.x + (size_t)m * DM) + lane)[64 * j]; vb[j] = has2 ? ((const GAS f32x4*)(p.x + (size_t)m2 * DM) + lane)[64 * j] : (f32x4){0.f, 0.f, 0.f, 0.f}; }
#pragma unroll
        for (int r = 0; r < 2; ++r) { if (r == 1 && !has2) break; const int mm = r ? m2 : m;
            GAS unsigned long long* o8 = (GAS unsigned long long*)(XB + (size_t)mm * DM) + lane; GAS unsigned* o4 = (GAS unsigned*)(ws + WS_XB8 + (size_t)mm * DM) + lane;
#pragma unroll
            for (int j = 0; j < 8; ++j) { const f32x4 v = r ? vb[j] : va[j]; o8[64 * j] = (unsigned long long)pk2(v.x, v.y) | ((unsigned long long)pk2(v.z, v.w) << 32);
                o4[64 * j] = pk4_fp8(v.x * X8_SCALE, v.y * X8_SCALE, v.z * X8_SCALE, v.w * X8_SCALE); } }
    }
    { bf16* WRT = (bf16*)(ws + WS_WRT); for (int i = gw * 64 + lane; i < NE * DM; i += NGW * 64) WRT[i] = (bf16)(pkh2(p.w_router[(size_t)(i & (DM - 1)) * NE + (i >> 11)], 0.f) & 0xffffu); }
    float* B1 = (float*)(ws + WS_BIAS1);
    for (int n = gw * 64 + lane; n < NP1; n += NGW * 64) { const int sc = ColWin()(n); B1[n] = sc >= 0 ? p.b_in[sc] : 0.f; }
}

constexpr int CW_QHEAD = 20480;
static_assert((CW_QHEAD + 64) * 4 <= (int)CTL_ZERO_BYTES && (CW_CNT + 64 * 32) * 4 <= (int)CTL_ZERO_BYTES && (CW_BAR + 3456) * 4 <= (int)CTL_ZERO_BYTES, "control words inside the per-call memset");
__device__ __forceinline__ CvItem moe_cv_item(const KP& p, int r, int lane) {
    constexpr int I_GU = 16 * 128, I_D = 16 * 64; const int kr = lane >> 3, ng = lane & 7; CvItem it;
    if (r < NE * I_GU) { const int e = r / I_GU, q = r % I_GU, n0 = 32 * (q % 128), k0 = 128 * (q / 128);
        it.src = (const GAS float*)(p.w_gu + (size_t)e * DM * 4096 + (size_t)(k0 + 4 * kr) * 4096 + ColGu()(n0 + 4 * ng)); it.dst = p.ws + WS_WGU + (size_t)e * 4096 * DM + (size_t)n0 * DM + k0; it.ldw = 4096; }
    else { r -= NE * I_GU; const int e = r / I_D, q = r % I_D, n0 = 32 * (q % 64), k0 = 128 * (q / 64);
        it.src = (const GAS float*)(p.w_down + (size_t)e * DM * DM + (size_t)(k0 + 4 * kr) * DM + n0 + 4 * ng); it.dst = p.ws + WS_WD + (size_t)e * DM * DM + (size_t)n0 * DM + k0; it.ldw = DM; }
    return it;
}
__device__ __forceinline__ void moe_convert_queue(const KP& p, LAS unsigned char* lds, gu32* ctl, int wave, int lane) {
    LAS unsigned* scr = (LAS unsigned*)(lds + wave * 16384);
    constexpr int NQ = NE * (16 * 128 + 16 * 64), QCHUNK = 8;
    static_assert(NQ % QCHUNK == 0, "queue chunking");
    for (;;) {
        unsigned base = 0; if (lane == 0) base = __hip_atomic_fetch_add(ctl + CW_QHEAD, (unsigned)QCHUNK, RLX_AGENT);
        base = (unsigned)__builtin_amdgcn_readfirstlane((int)base);
        if (base >= (unsigned)NQ) break;
        f32x4 va[4][4], vb[4][4]; CvItem ia = moe_cv_item(p, (int)base, lane), ib = ia;
        cv_load(va, ia);
#pragma unroll
        for (int j = 0; j < QCHUNK; j += 2) {
            ib = moe_cv_item(p, (int)base + j + 1, lane); cv_load(vb, ib);
            cv_finish(va, ia, DM, W8_SCALE, scr, lane);
            if (j + 2 < QCHUNK) { ia = moe_cv_item(p, (int)base + j + 2, lane); cv_load(va, ia); }
            cv_finish(vb, ib, DM, W8_SCALE, scr, lane);
        }
    }
}

struct EpiProj {
    static constexpr bool PERM = true, AFTER_DRAIN = false, CHAIN = false;
    bf16* PROJ; float* SMALL; const float* bias; float inv;
    __device__ __forceinline__ void operator()(const pg8::f32x4 (&acc)[2][2][4][2], const pg8::Unit& u, int wr, int wc, int fr, int fq) const {
        const int row0 = u.pm * 256 + wr * 64 + fr;
        if (u.pn == 40) {
            if (wc == 0) {
                const float* bp = bias + 10240 + 8 * fq;
                const f32x4 b0 = *(const f32x4*)bp, b1 = *(const f32x4*)(bp + 4);
#pragma unroll
                for (int ai = 0; ai < 2; ++ai)
#pragma unroll
                    for (int m = 0; m < 4; ++m) { float* rp = SMALL + (size_t)(row0 + ai * 128 + m * 16) * 32 + 8 * fq;
                        *(f32x4*)rp = acc[ai][0][m][0] * inv + b0; *(f32x4*)(rp + 4) = acc[ai][0][m][1] * inv + b1; }
            }
            return;
        }
        const int pn = u.pn;
        const int act = (pn >= 8 && pn < 12) || pn >= 24 ? 1 : ((pn >= 20 && pn < 24) ? 2 : 0);
        const int col0 = pn * 256 + wc * 32 + 8 * fq;
        f32x4 bv[2][2];
#pragma unroll
        for (int bj = 0; bj < 2; ++bj)
#pragma unroll
            for (int n = 0; n < 2; ++n) bv[bj][n] = *(const f32x4*)(bias + col0 + bj * 128 + 4 * n);
#pragma unroll
        for (int ai = 0; ai < 2; ++ai)
#pragma unroll
            for (int m = 0; m < 4; ++m) { bf16* rowp = PROJ + (size_t)(row0 + ai * 128 + m * 16) * NPROJ + col0;
#pragma unroll
                for (int bj = 0; bj < 2; ++bj) { const f32x4 p0 = acc[ai][bj][m][0] * inv + bv[bj][0], p1 = acc[ai][bj][m][1] * inv + bv[bj][1];
                    float r[8] = {p0.x, p0.y, p0.z, p0.w, p1.x, p1.y, p1.z, p1.w};
                    if (act) {
#pragma unroll
                        for (int j = 0; j < 8; ++j) { const float sg = sigmoid_fast(r[j]); r[j] = act == 1 ? sg : r[j] * sg; }
                    }
                    if (pn >= 24) {
                        const unsigned long long w8 = (unsigned long long)pk4_u8(r[0], r[1], r[2], r[3]) | ((unsigned long long)pk4_u8(r[4], r[5], r[6], r[7]) << 32);
                        *(unsigned long long*)((unsigned char*)PROJ + (WS_GATES - WS_PROJ) + (size_t)(row0 + ai * 128 + m * 16) * 4096 + (col0 - PC_GATEM) + bj * 128) = w8;
                    } else {
                        pg8::u32x4 w; w.x = pg8::cvt_pk_bf16(r[0], r[1]); w.y = pg8::cvt_pk_bf16(r[2], r[3]); w.z = pg8::cvt_pk_bf16(r[4], r[5]); w.w = pg8::cvt_pk_bf16(r[6], r[7]);
                        *(pg8::u32x4*)(rowp + bj * 128) = w; } } }
    }
};
struct EpiBranchFused {
    static constexpr bool PERM = true, AFTER_DRAIN = false, CHAIN = true;
    bf16* Z; const unsigned char* GATES;
    __device__ __forceinline__ bool chain(pg8::f32x4 (&acc)[2][2][4][2], const pg8::Unit& u, int wr, int wc, int fr, int fq) const {
        const bool second = u.pm >= 128; const int pm = second ? u.pm - 128 : u.pm, pn = second ? u.pn - 8 : u.pn;
        const int row0 = pm * 256 + wr * 64 + fr, col0 = pn * 256 + wc * 32 + 8 * fq;
        if (!second) {
            unsigned long long gga[2][4][2], gma[2][4][2];
#pragma unroll
            for (int ai = 0; ai < 2; ++ai)
#pragma unroll
                for (int m = 0; m < 4; ++m)
#pragma unroll
                    for (int bj = 0; bj < 2; ++bj) { const unsigned char* gp = GATES + (size_t)(row0 + ai * 128 + m * 16) * 4096 + col0 + bj * 128;
                        gma[ai][m][bj] = *(const GAS unsigned long long*)gp; gga[ai][m][bj] = *(const GAS unsigned long long*)(gp + 2048); }
#pragma unroll
            for (int ai = 0; ai < 2; ++ai)
#pragma unroll
                for (int m = 0; m < 4; ++m)
#pragma unroll
                    for (int bj = 0; bj < 2; ++bj) { float gg[8], gm[8]; unpack8_u8(gga[ai][m][bj], gg); unpack8_u8(gma[ai][m][bj], gm);
#pragma unroll
                        for (int j = 0; j < 4; ++j) { acc[ai][bj][m][0][j] *= gm[j] * __builtin_amdgcn_rcpf(fmaxf(gg[j], 0.5f)); acc[ai][bj][m][1][j] *= gm[4 + j] * __builtin_amdgcn_rcpf(fmaxf(gg[4 + j], 0.5f)); } }
            return true;
        }
        unsigned long long gga[2][4][2];
#pragma unroll
        for (int ai = 0; ai < 2; ++ai)
#pragma unroll
            for (int m = 0; m < 4; ++m)
#pragma unroll
                for (int bj = 0; bj < 2; ++bj) gga[ai][m][bj] = *(const GAS unsigned long long*)(GATES + (size_t)(row0 + ai * 128 + m * 16) * 4096 + 2048 + col0 + bj * 128);
#pragma unroll
        for (int ai = 0; ai < 2; ++ai)
#pragma unroll
            for (int m = 0; m < 4; ++m)
#pragma unroll
                for (int bj = 0; bj < 2; ++bj) { float gg[8]; unpack8_u8(gga[ai][m][bj], gg);
#pragma unroll
                    for (int j = 0; j < 8; ++j) gg[j] = fmaxf(gg[j], 0.5f) * (1.f / 255.f);
                    const pg8::f32x4 a0 = acc[ai][bj][m][0], a1 = acc[ai][bj][m][1];
                    pg8::u32x4 w; w.x = pg8::cvt_pk_bf16(gg[0] * a0[0], gg[1] * a0[1]); w.y = pg8::cvt_pk_bf16(gg[2] * a0[2], gg[3] * a0[3]);
                    w.z = pg8::cvt_pk_bf16(gg[4] * a1[0], gg[5] * a1[1]); w.w = pg8::cvt_pk_bf16(gg[6] * a1[2], gg[7] * a1[3]);
                    *(pg8::u32x4*)(Z + (size_t)(row0 + ai * 128 + m * 16) * DM + col0 + bj * 128) = w; }
        return false;
    }
};
struct PairOrder : pg8::StaticOrder {
    __device__ __forceinline__ bool next(int i, pg8::Unit& u) const { if (!pg8::StaticOrder::next(i >> 1, u)) return false; if (i & 1) { u.pm += 128; u.pn += 8; } return true; } };
struct EpiMix {
    static constexpr bool PERM = true, AFTER_DRAIN = false, CHAIN = false;
    bf16* MIX;
    __device__ __forceinline__ void operator()(const pg8::f32x4 (&acc)[2][2][4][2], const pg8::Unit& u, int wr, int wc, int fr, int fq) const {
        const int row0 = u.pm * 256 + wr * 64 + fr, col0 = u.pn * 256 + wc * 32 + 8 * fq;
#pragma unroll
        for (int ai = 0; ai < 2; ++ai)
#pragma unroll
            for (int m = 0; m < 4; ++m) { bf16* rowp = MIX + (size_t)(row0 + ai * 128 + m * 16) * DM + col0;
#pragma unroll
                for (int bj = 0; bj < 2; ++bj) { const pg8::f32x4 v0 = acc[ai][bj][m][0], v1 = acc[ai][bj][m][1];
                    pg8::u32x4 w; w.x = pg8::cvt_pk_bf16(v0[0], v0[1]); w.y = pg8::cvt_pk_bf16(v0[2], v0[3]); w.z = pg8::cvt_pk_bf16(v1[0], v1[1]); w.w = pg8::cvt_pk_bf16(v1[2], v1[3]);
                    *(pg8::u32x4*)(rowp + bj * 128) = w; } }
    }
};
struct EpiSwiglu {
    static constexpr bool PERM = true, AFTER_DRAIN = false, CHAIN = false;
    unsigned char* ACT; const float* b_gu;
    __device__ __forceinline__ void operator()(const pg8::f32x4 (&acc)[2][2][4][2], const pg8::Unit& u, int wr, int wc, int fr, int fq) const {
        const int e = u.pn >> 4, jt = u.pn & 15;
        const int row0 = u.pm * 256 + wr * 64 + fr, c0 = 128 * jt + wc * 32 + 8 * fq;
        const float* bg = b_gu + (size_t)e * 4096 + c0; constexpr float inv = 1.f / (X8_SCALE * W8_SCALE);
        const f32x4 bg0 = *(const f32x4*)bg, bg1 = *(const f32x4*)(bg + 4), bl0 = *(const f32x4*)(bg + 2048), bl1 = *(const f32x4*)(bg + 2052);
#pragma unroll
        for (int ai = 0; ai < 2; ++ai)
#pragma unroll
            for (int m = 0; m < 4; ++m) { const size_t row = (size_t)(row0 + ai * 128 + m * 16);
                const f32x4 g0 = acc[ai][0][m][0] * inv + bg0, g1 = acc[ai][0][m][1] * inv + bg1, l0 = acc[ai][1][m][0] * inv + bl0, l1 = acc[ai][1][m][1] * inv + bl1;
                float r[8];
#pragma unroll
                for (int j = 0; j < 4; ++j) {
                    const float a = fminf(g0[j], 7.f), b = fminf(fmaxf(l0[j], -7.f), 7.f); r[j] = a * sigmoid_fast(1.702f * a) * (b + 1.f) * A8_SCALE;
                    const float a2 = fminf(g1[j], 7.f), b2 = fminf(fmaxf(l1[j], -7.f), 7.f); r[4 + j] = a2 * sigmoid_fast(1.702f * a2) * (b2 + 1.f) * A8_SCALE; }
                const unsigned long long w = (unsigned long long)pk4_fp8(r[0], r[1], r[2], r[3]) | ((unsigned long long)pk4_fp8(r[4], r[5], r[6], r[7]) << 32);
                *(unsigned long long*)(ACT + row * DFF + c0) = w; }
    }
};
struct EpiDown {
    static constexpr bool PERM = true, AFTER_DRAIN = false, CHAIN = false;
    unsigned char* OUTS; const float* b_down;
    __device__ __forceinline__ void operator()(const pg8::f32x4 (&acc)[2][2][4][2], const pg8::Unit& u, int wr, int wc, int fr, int fq) const {
        const int e = u.pn >> 3, jt = u.pn & 7;
        const int row0 = u.pm * 256 + wr * 64 + fr, c0 = 256 * jt + wc * 32 + 8 * fq;
        const float* bd = b_down + (size_t)e * DM + c0; constexpr float inv = O8_SCALE / (A8_SCALE * W8_SCALE);
        f32x4 bv[2][2];
#pragma unroll
        for (int bj = 0; bj < 2; ++bj)
#pragma unroll
            for (int n = 0; n < 2; ++n) bv[bj][n] = *(const f32x4*)(bd + bj * 128 + 4 * n) * O8_SCALE;
#pragma unroll
        for (int ai = 0; ai < 2; ++ai)
#pragma unroll
            for (int m = 0; m < 4; ++m) { unsigned char* rowp = OUTS + (size_t)(row0 + ai * 128 + m * 16) * DM + c0;
#pragma unroll
                for (int bj = 0; bj < 2; ++bj) { const f32x4 v0 = acc[ai][bj][m][0] * inv + bv[bj][0], v1 = acc[ai][bj][m][1] * inv + bv[bj][1];
                    *(unsigned long long*)(rowp + bj * 128) = (unsigned long long)pk4_fp8(v0[0], v0[1], v0[2], v0[3]) | ((unsigned long long)pk4_fp8(v1[0], v1[1], v1[2], v1[3]) << 32); } }
    }
};
struct SubsetOrderBf : pg8::StaticOrder { __device__ __forceinline__ bool next(int i, pg8::Unit& u) const { if (!pg8::StaticOrder::next(i, u)) return false; u.pn = bf_tile(u.pn); return true; } };
struct SubsetOrderF8 : pg8::StaticOrder { __device__ __forceinline__ bool next(int i, pg8::Unit& u) const { if (!pg8::StaticOrder::next(i, u)) return false; u.pn = f8_tile(u.pn); return true; }
    __device__ __forceinline__ unsigned a_row(const pg8::Unit& u, int r) const { return (unsigned)(u.pm * 256 + r); } };
struct MoeOrder {
    const LAS int* tst; int G, c, nN;
    __device__ __forceinline__ bool next(int i, pg8::Unit& u) const {
        int rt, nt;
        if (G == 256) {
            const int x = c & 7, j = c >> 3;
            if (nN == 16) { rt = 16 * i + 4 * (x >> 1) + (j >> 3); nt = 8 * (x & 1) + (j & 7); } else { rt = 32 * i + 4 * x + (j >> 3); nt = j & 7; }
            if (rt >= tst[32]) return false;
        } else { const int L = i * G + c; const int total = tst[32] * nN; if (L >= total) return false; rt = L / nN; nt = L % nN; }
        int e = 0;
#pragma unroll 1
        for (int k = 1; k < 32; ++k) e += (tst[k] <= rt) ? 1 : 0;
        u.pm = rt; u.pn = e * nN + nt; return true;
    }
    __device__ __forceinline__ void a_ready(const pg8::Unit&) const {}
    __device__ __forceinline__ void done(const pg8::Unit&) const {}
    const int* slot;
    __device__ __forceinline__ unsigned a_row(const pg8::Unit& u, int r) const {
        if (!slot) return (unsigned)(u.pm * 256 + r);
        const int e = u.pn / nN; int idx = (u.pm - tst[e]) * 256 + r; const int cnt = tst[33 + e]; idx = idx < cnt ? idx : cnt - 1;
        return (unsigned)slot[(size_t)e * T + idx]; }
};
__device__ __forceinline__ void moe_tables(const gu32* ctl, LAS int* tst, int tid) {
    if (tid < 32) tst[33 + tid] = (int)__hip_atomic_load(ctl + CW_CNT + 64 * tid, RLX_AGENT);
    __syncthreads();
    if (tid == 0) { int a = 0; for (int e = 0; e < 32; ++e) { tst[e] = a; a += (tst[33 + e] + 255) >> 8; } tst[32] = a; }
    __syncthreads();
}

struct ConvW { float w[4][8]; float b[8]; };
__device__ __forceinline__ void load_convw(ConvW& cw, const float* conv_w, const float* conv_b, int ch) {
#pragma unroll
    for (int j = 0; j < 4; ++j) { const f32x4 a = *(const f32x4*)(conv_w + j * 1024 + ch), b = *(const f32x4*)(conv_w + j * 1024 + ch + 4);
        cw.w[j][0] = a.x; cw.w[j][1] = a.y; cw.w[j][2] = a.z; cw.w[j][3] = a.w; cw.w[j][4] = b.x; cw.w[j][5] = b.y; cw.w[j][6] = b.z; cw.w[j][7] = b.w; }
    const f32x4 a = *(const f32x4*)(conv_b + ch), b = *(const f32x4*)(conv_b + ch + 4);
    cw.b[0] = a.x; cw.b[1] = a.y; cw.b[2] = a.z; cw.b[3] = a.w; cw.b[4] = b.x; cw.b[5] = b.y; cw.b[6] = b.z; cw.b[7] = b.w;
}
__device__ __forceinline__ void conv_silu8(const bf16* src, size_t trow, int pos, const ConvW& cw, float (&o)[8]) {
#pragma unroll
    for (int d = 0; d < 8; ++d) o[d] = cw.b[d];
#pragma unroll
    for (int j = 0; j < 4; ++j) { if (pos - 3 + j >= 0) { const v4u r = *(const GAS v4u*)(src + (trow - 3 + j) * NPROJ); float f[8]; unpack8(r, f);
#pragma unroll
            for (int d = 0; d < 8; ++d) o[d] += cw.w[j][d] * f[d]; } }
#pragma unroll
    for (int d = 0; d < 8; ++d) o[d] = o[d] * sigmoid_fast(o[d]);
}
__device__ __forceinline__ void gla_cum(const KP& p, const float* SMALL, size_t t0, int h, LAS float* cumL, LAS float* tot, LAS float* glr_s, int tid) {
    for (int i = tid; i < 64 * 16; i += NTHR) glr_s[i] = SMALL[(t0 + (i >> 4)) * 32 + 8 + (i & 15)];
    const int dk = tid & 127, sq = tid >> 7;
    float wg[16];
#pragma unroll
    for (int r = 0; r < 16; ++r) wg[r] = p.w_gla[r * 512 + h * 128 + dk];
    const float bgv = p.b_gla[h * 128 + dk];
    __syncthreads();
    float run = 0.f; float loc[16];
#pragma unroll
    for (int i = 0; i < 16; ++i) { const int s = 16 * sq + i; float z = bgv;
#pragma unroll
        for (int r = 0; r < 16; ++r) z += glr_s[s * 16 + r] * wg[r];
        run += logsigmoid_fast(z) * (1.f / 16.f); loc[i] = run; }
    tot[sq * 128 + dk] = run;
    __syncthreads();
    float off = 0.f;
#pragma unroll
    for (int j = 0; j < 3; ++j) off += (j < sq) ? tot[j * 128 + dk] : 0.f;
#pragma unroll
    for (int i = 0; i < 16; ++i) cumL[(16 * sq + i) * 128 + dk] = loc[i] + off;
    __syncthreads();
}
constexpr int VN_PITCH = 528;
typedef short v4i16_t __attribute__((ext_vector_type(4)));
template <int PITCH> __device__ __forceinline__ bf16x8 frag_tr(const LAS unsigned char* tile, int ct, int ks, int fr, int fq) {
    const LAS unsigned char* a = tile + (32 * ks + 8 * fq + (fr >> 2)) * PITCH + (16 * ct + 4 * (fr & 3)) * 2;
    const v4i16_t lo = __builtin_amdgcn_ds_read_tr16_b64_v4i16((LAS v4i16_t*)a), hi = __builtin_amdgcn_ds_read_tr16_b64_v4i16((LAS v4i16_t*)(a + 4 * PITCH));
    return __builtin_shufflevector(lo, hi, 0, 1, 2, 3, 4, 5, 6, 7);
}
__device__ __forceinline__ bf16x8 vfrag_tr(const LAS unsigned char* vN, int dvt, int ks, int fr, int fq) { return frag_tr<VN_PITCH>(vN, dvt, ks, fr, fq); }
constexpr int KN_PITCH = 272;
__device__ __forceinline__ void vN_store(LAS unsigned char* vN, int idx, v4u r) { *(LAS v4u*)(vN + (idx >> 5) * VN_PITCH + (idx & 31) * 16) = r; }
__device__ __forceinline__ void state_mfma_store(const LAS unsigned char* vN, const LAS unsigned char* keN, bf16* dst, int wave, int lane) {
    const int fr = lane & 15, fq = lane >> 4;
    bf16x8 bvv[2][2];
#pragma unroll
    for (int i = 0; i < 2; ++i)
#pragma unroll
        for (int ks = 0; ks < 2; ++ks) bvv[i][ks] = vfrag_tr(vN, 2 * wave + i, ks, fr, fq);
#pragma unroll
    for (int j = 0; j < 8; ++j) { bf16x8 a[2];
#pragma unroll
        for (int ks = 0; ks < 2; ++ks) a[ks] = frag_tr<KN_PITCH>(keN, j, ks, fr, fq);
#pragma unroll
        for (int i = 0; i < 2; ++i) { f32x4 acc = {0.f, 0.f, 0.f, 0.f};
#pragma unroll
            for (int ks = 0; ks < 2; ++ks) acc = __builtin_amdgcn_mfma_f32_16x16x32_bf16(a[ks], bvv[i][ks], acc, 0, 0, 0);
            *(GAS unsigned long long*)(dst + (size_t)(16 * (2 * wave + i) + fr) * 128 + 16 * j + 4 * fq) = (unsigned long long)pk2(acc[0], acc[1]) | ((unsigned long long)pk2(acc[2], acc[3]) << 32); } }
}

struct LocPreM { v4u rv[4], rq[5], rk[5]; float fp, ip; };
struct LocOffM { unsigned vo; int ro; };
__device__ __forceinline__ void locm_prefetch(LocPreM& P, const LocOffM& O, const KP& p, int cid, int lane, int wave, int sp) {
    unsigned char* ws = p.ws;
    const int bh = cid >> 6, c = cid & 63, b = bh >> 2, h = bh & 3; const size_t t0 = (size_t)b * SEQ + c * 64;
    const char* vb = (const char*)((const bf16*)(ws + WS_PROJ) + t0 * NPROJ + PC_MV + h * 256);
    const char* qb = (const char*)((const bf16*)(ws + WS_PROJ) + t0 * NPROJ + PC_MQ + h * 128);
    const char* kb = (const char*)((const bf16*)(ws + WS_PROJ) + t0 * NPROJ + PC_MK + h * 128);
#pragma unroll
    for (int i = 0; i < 4; ++i) P.rv[i] = *(const GAS v4u*)(vb + (size_t)i * 16 * NPROJ * 2 + O.vo);
#pragma unroll
    for (int j = 0; j < 5; ++j) { const bool ok = (c > 0) || (2 * sp - 3 + j >= 0);
        const long off = (long)O.ro + (long)j * NPROJ * 2;
        P.rq[j] = ok ? *(const GAS v4u*)(qb + off) : (v4u){0u, 0u, 0u, 0u}; P.rk[j] = ok ? *(const GAS v4u*)(kb + off) : (v4u){0u, 0u, 0u, 0u}; }
    P.fp = 0.f; P.ip = 0.f;
    if (wave == 0) { const float* SMALL = (const float*)(ws + WS_SMALL); P.fp = SMALL[(t0 + lane) * 32 + 4 + h]; P.ip = SMALL[(t0 + lane) * 32 + h]; }
}
__device__ __forceinline__ void conv2_silu8(const v4u (&r)[5], const ConvW& cw, float (&o0)[8], float (&o1)[8]) {
    float f[5][8];
#pragma unroll
    for (int j = 0; j < 5; ++j) unpack8(r[j], f[j]);
#pragma unroll
    for (int d = 0; d < 8; ++d) { float a = cw.b[d], bb = cw.b[d];
#pragma unroll
        for (int j = 0; j < 4; ++j) { a += cw.w[j][d] * f[j][d]; bb += cw.w[j][d] * f[j + 1][d]; }
        o0[d] = a * sigmoid_fast(a); o1[d] = bb * sigmoid_fast(bb); }
}
template <int LOCX = 0> __device__ __forceinline__ void mixer_local_mlstm(const KP& p, LAS unsigned char* L, int bx, int G, int tid, int lane, int wave) {
    unsigned char* ws = p.ws;
    LAS unsigned char* vN = L + 0; LAS unsigned char* keN = L + 36864; LAS float* wexp = (LAS float*)(L + 55296);
    const int d8 = tid & 15, sp = tid >> 4;
    if (bx >= NCHUNK) return;
    LocOffM O; O.vo = (unsigned)(((tid >> 5) * NPROJ + (tid & 31) * 8) * 2); O.ro = ((2 * sp - 3) * NPROJ + d8 * 8) * 2;
    LocPreM P; locm_prefetch(P, O, p, bx, lane, wave, sp);
#pragma unroll 1
    for (int cid = bx; cid < NCHUNK; cid += G) {
        const int bh = cid >> 6, c = cid & 63, b = bh >> 2, h = bh & 3; const size_t t0 = (size_t)b * SEQ + c * 64;
        if (wave == 0) {
            float bc = logsigmoidf(P.fp); const float ip = P.ip;
#pragma unroll
            for (int o = 1; o < 64; o <<= 1) { const float n = __shfl_up(bc, o); if (lane >= o) bc += n; }
            const float bend = __shfl(bc, 63);
            const float w = bend - bc + ip; const float g = wave_max(w);
            wexp[lane] = expf(w - g);
            if (lane == 0) { ((float*)(ws + WS_MISC + MISC_GEND))[cid] = g; ((float*)(ws + WS_MISC + MISC_BEND))[cid] = bend; }
        }
#pragma unroll
        for (int i = 0; i < ((LOCX & 8) ? 1 : 4); ++i) vN_store(vN, tid + NTHR * i, P.rv[i]);
        float k0[8], k1[8];
        { ConvW cwq; load_convw(cwq, p.conv_w, p.conv_b, h * 128 + d8 * 8); float q0[8], q1[8]; if (!(LOCX & 4)) conv2_silu8(P.rq, cwq, q0, q1); else { for (int d = 0; d < 8; ++d) { q0[d] = bf2f(P.rq[0].x) + d; q1[d] = bf2f(P.rq[4].y) + d; } } bf16* QC = (bf16*)(ws + WS_QC) + (t0 + 2 * sp) * 512 + h * 128 + d8 * 8;
          v4u w; w.x = pk2(q0[0], q0[1]); w.y = pk2(q0[2], q0[3]); w.z = pk2(q0[4], q0[5]); w.w = pk2(q0[6], q0[7]); *(GAS v4u*)QC = w;
          w.x = pk2(q1[0], q1[1]); w.y = pk2(q1[2], q1[3]); w.z = pk2(q1[4], q1[5]); w.w = pk2(q1[6], q1[7]); *(GAS v4u*)(QC + 512) = w; }
        { ConvW cwk; load_convw(cwk, p.conv_w, p.conv_b, 512 + h * 128 + d8 * 8); if (!(LOCX & 4)) conv2_silu8(P.rk, cwk, k0, k1); else { for (int d = 0; d < 8; ++d) { k0[d] = bf2f(P.rk[0].x) + d; k1[d] = bf2f(P.rk[4].y) + d; } } bf16* KC = (bf16*)(ws + WS_KC) + (t0 + 2 * sp) * 512 + h * 128 + d8 * 8;
#pragma unroll
          for (int d = 0; d < 8; ++d) { k0[d] *= RSQRT_DK; k1[d] *= RSQRT_DK; }
          v4u w; w.x = pk2(k0[0], k0[1]); w.y = pk2(k0[2], k0[3]); w.z = pk2(k0[4], k0[5]); w.w = pk2(k0[6], k0[7]); *(GAS v4u*)KC = w;
          w.x = pk2(k1[0], k1[1]); w.y = pk2(k1[2], k1[3]); w.z = pk2(k1[4], k1[5]); w.w = pk2(k1[6], k1[7]); *(GAS v4u*)(KC + 512) = w; }
        __syncthreads();
        if (cid + G < NCHUNK) locm_prefetch(P, O, p, cid + G, lane, wave, sp);
        __builtin_amdgcn_sched_barrier(0);
        { const float w0 = wexp[2 * sp], w1 = wexp[2 * sp + 1]; v4u w;
          w.x = pk2(k0[0] * w0, k0[1] * w0); w.y = pk2(k0[2] * w0, k0[3] * w0); w.z = pk2(k0[4] * w0, k0[5] * w0); w.w = pk2(k0[6] * w0, k0[7] * w0); *(LAS v4u*)(keN + (2 * sp) * KN_PITCH + d8 * 16) = w;
          w.x = pk2(k1[0] * w1, k1[1] * w1); w.y = pk2(k1[2] * w1, k1[3] * w1); w.z = pk2(k1[4] * w1, k1[5] * w1); w.w = pk2(k1[6] * w1, k1[7] * w1); *(LAS v4u*)(keN + (2 * sp + 1) * KN_PITCH + d8 * 16) = w; }
        __syncthreads();
        if (!(LOCX & 2)) { const int dk = tid >> 2, qq = tid & 3; float sum = 0.f;
#pragma unroll
            for (int s = 0; s < 16; ++s) sum += bf2f(*(const LAS bf16*)(keN + (16 * qq + s) * KN_PITCH + dk * 2));
            sum += __shfl_xor(sum, 1); sum += __shfl_xor(sum, 2);
            if (qq == 0) ((float*)(ws + WS_MISC + MISC_DN))[(size_t)cid * 128 + dk] = sum; }
        if (!(LOCX & 1)) state_mfma_store(vN, keN, (bf16*)(ws + WS_MSTATE) + (size_t)cid * 32768, wave, lane);
        __syncthreads();
    }
}
struct LocPreG { v4u rv[4], rq[2], rk[2]; float g0, g1; };
__device__ __forceinline__ void locg_prefetch(LocPreG& P, unsigned vo, unsigned qo, const KP& p, int cid, int tid) {
    unsigned char* ws = p.ws;
    const int bh = cid >> 6, c = cid & 63, b = bh >> 2, h = bh & 3; const size_t t0 = (size_t)b * SEQ + c * 64;
    const char* vb = (const char*)((const bf16*)(ws + WS_PROJ) + t0 * NPROJ + PC_GV + h * 256);
    const char* qb = (const char*)((const bf16*)(ws + WS_PROJ) + t0 * NPROJ + PC_GQ + h * 128);
    const char* kb = (const char*)((const bf16*)(ws + WS_PROJ) + t0 * NPROJ + PC_GK + h * 128);
#pragma unroll
    for (int i = 0; i < 4; ++i) P.rv[i] = *(const GAS v4u*)(vb + (size_t)i * 16 * NPROJ * 2 + vo);
#pragma unroll
    for (int i = 0; i < 2; ++i) { P.rq[i] = *(const GAS v4u*)(qb + (size_t)i * 32 * NPROJ * 2 + qo); P.rk[i] = *(const GAS v4u*)(kb + (size_t)i * 32 * NPROJ * 2 + qo); }
    const float* SMALL = (const float*)(ws + WS_SMALL);
    P.g0 = SMALL[(t0 + (tid >> 4)) * 32 + 8 + (tid & 15)]; P.g1 = SMALL[(t0 + 32 + (tid >> 4)) * 32 + 8 + (tid & 15)];
}
__device__ __forceinline__ void mixer_local_gla(const KP& p, LAS unsigned char* L, int bx, int G, int tid, int lane, int wave) {
    unsigned char* ws = p.ws;
    LAS unsigned char* vN = L + 0; LAS unsigned char* keN = L + 36864;
    LAS float* cumL = (LAS float*)(L + 57344); LAS float* tot = (LAS float*)(L + 57344 + 32768); LAS float* glr_s = (LAS float*)(L + 57344 + 32768 + 2048);
    const int d8 = tid & 15;
    if (bx >= NCHUNK) return;
    const unsigned vo = (unsigned)(((tid >> 5) * NPROJ + (tid & 31) * 8) * 2), qo = (unsigned)(((tid >> 4) * NPROJ + d8 * 8) * 2);
    LocPreG P; locg_prefetch(P, vo, qo, p, bx, tid);
    int hw = -1; float wg[16]; float bgv = 0.f;
#pragma unroll
    for (int r = 0; r < 16; ++r) wg[r] = 0.f;
#pragma unroll 1
    for (int cid = bx; cid < NCHUNK; cid += G) {
        const int bh = cid >> 6, c = cid & 63, b = bh >> 2, h = bh & 3; const size_t t0 = (size_t)b * SEQ + c * 64;
        const int dk = tid & 127, sq = tid >> 7;
        if (h != hw) {
#pragma unroll
            for (int r = 0; r < 16; ++r) wg[r] = p.w_gla[r * 512 + h * 128 + dk];
            bgv = p.b_gla[h * 128 + dk]; hw = h; }
        glr_s[tid] = P.g0; glr_s[tid + 512] = P.g1;
#pragma unroll
        for (int i = 0; i < 4; ++i) vN_store(vN, tid + NTHR * i, P.rv[i]);
        v4u rq[2], rk[2];
#pragma unroll
        for (int i = 0; i < 2; ++i) { rq[i] = P.rq[i]; rk[i] = P.rk[i]; }
        __syncthreads();
        if (cid + G < NCHUNK) locg_prefetch(P, vo, qo, p, cid + G, tid);
        __builtin_amdgcn_sched_barrier(0);
        { float run = 0.f; float loc[16];
#pragma unroll
          for (int i = 0; i < 16; ++i) { const int s = 16 * sq + i; float z = bgv;
#pragma unroll
              for (int r = 0; r < 16; ++r) z += glr_s[s * 16 + r] * wg[r];
              run += logsigmoid_fast(z) * (1.f / 16.f); loc[i] = run; }
          tot[sq * 128 + dk] = run;
          __syncthreads();
          float off = 0.f;
#pragma unroll
          for (int j = 0; j < 3; ++j) off += (j < sq) ? tot[j * 128 + dk] : 0.f;
#pragma unroll
          for (int i = 0; i < 16; ++i) cumL[(16 * sq + i) * 128 + dk] = loc[i] + off;
          __syncthreads(); }
        { bf16* QI = (bf16*)(ws + WS_QI); bf16* KI = (bf16*)(ws + WS_KI);
#pragma unroll
          for (int i = 0; i < 2; ++i) { const int s = (tid + NTHR * i) >> 4;
              float fq8[8], fk8[8], fe8[8]; unpack8(rq[i], fq8); unpack8(rk[i], fk8);
#pragma unroll
              for (int d = 0; d < 8; ++d) { const int dkk = d8 * 8 + d; const float cu = cumL[s * 128 + dkk], ce = cumL[63 * 128 + dkk];
                  fq8[d] *= RSQRT_DK * __expf(cu); fe8[d] = fk8[d] * __expf(ce - cu); fk8[d] *= __expf(-cu); }
              v4u w; w.x = pk2(fq8[0], fq8[1]); w.y = pk2(fq8[2], fq8[3]); w.z = pk2(fq8[4], fq8[5]); w.w = pk2(fq8[6], fq8[7]); *(GAS v4u*)(QI + (t0 + s) * 512 + h * 128 + d8 * 8) = w;
              w.x = pk2(fk8[0], fk8[1]); w.y = pk2(fk8[2], fk8[3]); w.z = pk2(fk8[4], fk8[5]); w.w = pk2(fk8[6], fk8[7]); *(GAS v4u*)(KI + (t0 + s) * 512 + h * 128 + d8 * 8) = w;
              w.x = pk2(fe8[0], fe8[1]); w.y = pk2(fe8[2], fe8[3]); w.z = pk2(fe8[4], fe8[5]); w.w = pk2(fe8[6], fe8[7]); *(LAS v4u*)(keN + s * KN_PITCH + d8 * 16) = w; } }
        if (tid < 128) ((float*)(ws + WS_MISC + MISC_GDEC))[(size_t)cid * 128 + tid] = __expf(cumL[63 * 128 + tid]);
        __syncthreads();
        state_mfma_store(vN, keN, (bf16*)(ws + WS_GSTATE) + (size_t)cid * 32768, wave, lane);
        __syncthreads();
    }
}

__device__ __forceinline__ void scan_phase(const KP& p, LAS unsigned char* L, int G, int tid) {
    unsigned char* ws = p.ws;
    LAS float* sg = (LAS float*)L; LAS float* sbe = sg + 2048; LAS float* sa = sg + 4096; LAS float* sc = sg + 6144;
    const float* GEND = (const float*)(ws + WS_MISC + MISC_GEND); const float* BEND = (const float*)(ws + WS_MISC + MISC_BEND);
    float* MPREV = (float*)(ws + WS_MISC + MISC_MPREV); float* NPREV = (float*)(ws + WS_MISC + MISC_NPREV);
    for (int i = tid; i < 2048; i += NTHR) { sg[i] = GEND[i]; sbe[i] = BEND[i]; }
    __syncthreads();
    if (tid < 32) { float m = 0.f;
        for (int c = 0; c < 64; ++c) { const int id = tid * 64 + c; const float g = sg[id], be = sbe[id];
            if (blockIdx.x == 0) MPREV[id] = m;
            const float mn = fmaxf(be + m, g); sa[id] = expf(be + m - mn); sc[id] = expf(g - mn); m = mn; } }
    __syncthreads();
    const int NT = G * NTHR, gt = blockIdx.x * NTHR + tid;
    const v4u* MST = (const v4u*)(ws + WS_MSTATE); v4u* MPC = (v4u*)(ws + WS_MPREV);
    for (int e = gt; e < NBH * 4096; e += NT) { const int bh = e >> 12, idx = e & 4095;
        const v4u* src = MST + (size_t)bh * 64 * 4096 + idx; v4u* dstp = MPC + (size_t)bh * 64 * 4096 + idx; float st[8];
#pragma unroll
        for (int q = 0; q < 8; ++q) st[q] = 0.f;
#pragma unroll 1
        for (int c0 = 0; c0 < 64; c0 += 16) { v4u d[16];
#pragma unroll
            for (int j = 0; j < 16; ++j) d[j] = src[(size_t)(c0 + j) * 4096];
#pragma unroll
            for (int j = 0; j < 16; ++j) { const int cid = bh * 64 + c0 + j; v4u o; o.x = pk2(st[0], st[1]); o.y = pk2(st[2], st[3]); o.z = pk2(st[4], st[5]); o.w = pk2(st[6], st[7]); dstp[(size_t)(c0 + j) * 4096] = o;
                const float a = sa[cid], cc = sc[cid]; float f[8]; unpack8(d[j], f);
#pragma unroll
                for (int q = 0; q < 8; ++q) st[q] = a * st[q] + cc * f[q]; } } }
    { const float* DN = (const float*)(ws + WS_MISC + MISC_DN);
      for (int e = gt; e < NBH * 128; e += NT) { const int bh = e >> 7, dk = e & 127; float st = 0.f;
#pragma unroll 1
          for (int c0 = 0; c0 < 64; c0 += 16) { float d[16];
#pragma unroll
              for (int j = 0; j < 16; ++j) d[j] = DN[(size_t)(bh * 64 + c0 + j) * 128 + dk];
#pragma unroll
              for (int j = 0; j < 16; ++j) { const int cid = bh * 64 + c0 + j; NPREV[cid * 128 + dk] = st; st = sa[cid] * st + sc[cid] * d[j]; } } } }
    const v4u* GST = (const v4u*)(ws + WS_GSTATE); v4u* GPC = (v4u*)(ws + WS_GPREV); const float* GDEC = (const float*)(ws + WS_MISC + MISC_GDEC);
    for (int e = gt; e < NBH * 4096; e += NT) { const int bh = e >> 12, idx = e & 4095, dk = (idx & 15) * 8;
        const v4u* src = GST + (size_t)bh * 64 * 4096 + idx; v4u* dstp = GPC + (size_t)bh * 64 * 4096 + idx; const float* dsrc = GDEC + (size_t)bh * 64 * 128 + dk; float st[8];
#pragma unroll
        for (int q = 0; q < 8; ++q) st[q] = 0.f;
#pragma unroll 1
        for (int c0 = 0; c0 < 64; c0 += 8) { v4u d[8]; f32x4 da[8], db[8];
#pragma unroll
            for (int j = 0; j < 8; ++j) { d[j] = src[(size_t)(c0 + j) * 4096]; da[j] = *(const f32x4*)(dsrc + (c0 + j) * 128); db[j] = *(const f32x4*)(dsrc + (c0 + j) * 128 + 4); }
#pragma unroll
            for (int j = 0; j < 8; ++j) { v4u o; o.x = pk2(st[0], st[1]); o.y = pk2(st[2], st[3]); o.z = pk2(st[4], st[5]); o.w = pk2(st[6], st[7]); dstp[(size_t)(c0 + j) * 4096] = o;
                float f[8]; unpack8(d[j], f);
                st[0] = da[j].x * st[0] + f[0]; st[1] = da[j].y * st[1] + f[1]; st[2] = da[j].z * st[2] + f[2]; st[3] = da[j].w * st[3] + f[3];
                st[4] = db[j].x * st[4] + f[4]; st[5] = db[j].y * st[5] + f[5]; st[6] = db[j].z * st[6] + f[6]; st[7] = db[j].w * st[7] + f[7]; } } }
}

struct OutPre { v4u rq[2], rk[2], rv[4]; bf16x8 ct[2][4]; float f0, f1, f2; };
struct OutOff { unsigned qo, vo, co; };
template <bool gla> __device__ __forceinline__ void out_prefetch(OutPre& P, const OutOff& O, const KP& p, int cid, int tid, int lane, int wave) {
    unsigned char* ws = p.ws;
    const int bh = cid >> 6, c = cid & 63, b = bh >> 2, h = bh & 3; const size_t t0 = (size_t)b * SEQ + c * 64;
    const char* qb = (const char*)((const bf16*)(ws + (gla ? WS_QI : WS_QC)) + t0 * 512 + h * 128);
    const char* kb = (const char*)((const bf16*)(ws + (gla ? WS_KI : WS_KC)) + t0 * 512 + h * 128);
    const char* vb = (const char*)((const bf16*)(ws + WS_PROJ) + t0 * NPROJ + (gla ? PC_GV : PC_MV) + h * 256);
    const char* cb = (const char*)((const bf16*)(ws + (gla ? WS_GPREV : WS_MPREV)) + (size_t)cid * 32768 + (size_t)(32 * wave) * 128);
#pragma unroll
    for (int i = 0; i < 2; ++i) { P.rq[i] = *(const GAS v4u*)(qb + (size_t)i * 32 * 512 * 2 + O.qo); P.rk[i] = *(const GAS v4u*)(kb + (size_t)i * 32 * 512 * 2 + O.qo); }
#pragma unroll
    for (int i = 0; i < 4; ++i) P.rv[i] = *(const GAS v4u*)(vb + (size_t)i * 16 * NPROJ * 2 + O.vo);
#pragma unroll
    for (int i = 0; i < 2; ++i)
#pragma unroll
        for (int ks = 0; ks < 4; ++ks) P.ct[i][ks] = *(const GAS bf16x8*)(cb + (size_t)(i * 16 * 128 + 32 * ks) * 2 + O.co);
    P.f0 = 0.f; P.f1 = 0.f; P.f2 = 0.f;
    if (!gla) { const float* SMALL = (const float*)(ws + WS_SMALL);
        if (wave == 0) { P.f0 = SMALL[(t0 + lane) * 32 + 4 + h]; P.f1 = SMALL[(t0 + lane) * 32 + h]; P.f2 = ((const float*)(ws + WS_MISC + MISC_MPREV))[cid]; }
        else if (tid < 192) P.f0 = ((const float*)(ws + WS_MISC + MISC_NPREV))[cid * 128 + tid - 64];
    }
}
template <bool gla> __device__ __forceinline__ void mixer_out_phase(const KP& p, LAS unsigned char* L, int bx, int G, int tid, int lane, int wave) {
    unsigned char* ws = p.ws;
    const int fr = lane & 15, fq = lane >> 4, d8 = tid & 15, rt = tid >> 3, seg = tid & 7;
    LAS bf16* q = (LAS bf16*)(L + 0); LAS bf16* k = (LAS bf16*)(L + 17408); LAS unsigned char* vN = L + 34816; LAS bf16* Sb = (LAS bf16*)(L + 71680);
    LAS float* sb = (LAS float*)(L + 80896); LAS float* sli = sb + 64; LAS float* smt = sb + 128; LAS float* sdec = sb + 192; LAS float* sden = sb + 256; LAS float* snp = sb + 320;
    LAS float* hbuf = (LAS float*)L;
    if (bx >= NCHUNK) return;
    OutOff O; O.qo = (unsigned)(((tid >> 4) * 512 + d8 * 8) * 2); O.vo = (unsigned)(((tid >> 5) * NPROJ + (tid & 31) * 8) * 2); O.co = (unsigned)((fr * 128 + 8 * fq) * 2);
    OutPre P; out_prefetch<gla>(P, O, p, bx, tid, lane, wave);
#pragma unroll 1
    for (int cid = bx; cid < NCHUNK; cid += G) {
        const int bh = cid >> 6, c = cid & 63, b = bh >> 2, h = bh & 3; const size_t t0 = (size_t)b * SEQ + c * 64;
        if (!gla) {
            if (wave == 0) {
                float bc = logsigmoidf(P.f0); const float ip = P.f1, mprev = P.f2;
#pragma unroll
                for (int o = 1; o < 64; o <<= 1) { const float n = __shfl_up(bc, o); if (lane >= o) bc += n; }
                float pm = ip - bc;
#pragma unroll
                for (int o = 1; o < 64; o <<= 1) { const float n = __shfl_up(pm, o); if (lane >= o) pm = fmaxf(pm, n); }
                const float mt = bc + fmaxf(mprev, pm);
                sb[lane] = bc; sli[lane] = ip; smt[lane] = mt; sdec[lane] = expf(bc + mprev - mt);
            } else if (tid < 192) snp[tid - 64] = P.f0;
        }
#pragma unroll
        for (int i = 0; i < 4; ++i) vN_store(vN, tid + NTHR * i, P.rv[i]);
#pragma unroll
        for (int i = 0; i < 2; ++i) { const int s = (tid + NTHR * i) >> 4; *(LAS v4u*)(q + s * 136 + d8 * 8) = P.rq[i]; *(LAS v4u*)(k + s * 136 + d8 * 8) = P.rk[i]; }
        bf16x8 bcx[2][4];
#pragma unroll
        for (int i = 0; i < 2; ++i)
#pragma unroll
            for (int ks = 0; ks < 4; ++ks) bcx[i][ks] = P.ct[i][ks];
        __syncthreads();
        if (cid + G < NCHUNK) out_prefetch<gla>(P, O, p, cid + G, tid, lane, wave);
        __builtin_amdgcn_sched_barrier(0);
        { const int tt = wave >> 1;
          bf16x8 a[4];
#pragma unroll
          for (int ks = 0; ks < 4; ++ks) a[ks] = *(const LAS bf16x8*)(q + (16 * tt + fr) * 136 + 32 * ks + 8 * fq);
#pragma unroll
          for (int i = 0; i < 2; ++i) { const int st = 2 * (wave & 1) + i; f32x4 acc = {0.f, 0.f, 0.f, 0.f};
#pragma unroll
              for (int ks = 0; ks < 4; ++ks) { const bf16x8 bb = *(const LAS bf16x8*)(k + (16 * st + fr) * 136 + 32 * ks + 8 * fq); acc = __builtin_amdgcn_mfma_f32_16x16x32_bf16(a[ks], bb, acc, 0, 0, 0); }
              const int s = 16 * st + fr;
#pragma unroll
              for (int r = 0; r < 4; ++r) { const int t = 16 * tt + 4 * fq + r; float wgt;
                  if (!gla) wgt = (s <= t) ? __expf(sb[t] - sb[s] + sli[s] - smt[t]) : 0.f; else wgt = (s <= t) ? 1.f : 0.f;
                  Sb[t * 72 + s] = (bf16)f2bf(acc[r] * wgt); } } }
        __syncthreads();
        if (!gla) {
            float v8[8]; unpack8(*(const LAS v4u*)(Sb + rt * 72 + 8 * seg), v8);
            float acc = ((v8[0] + v8[1]) + (v8[2] + v8[3])) + ((v8[4] + v8[5]) + (v8[6] + v8[7]));
            float qn = 0.f;
#pragma unroll
            for (int j = 0; j < 2; ++j) { float q8[8]; unpack8(*(const LAS v4u*)(q + rt * 136 + 16 * seg + 8 * j), q8);
                const f32x4 n0 = *(const LAS f32x4*)(snp + 16 * seg + 8 * j), n1 = *(const LAS f32x4*)(snp + 16 * seg + 8 * j + 4);
                qn += q8[0] * n0.x + q8[1] * n0.y + q8[2] * n0.z + q8[3] * n0.w + q8[4] * n1.x + q8[5] * n1.y + q8[6] * n1.z + q8[7] * n1.w; }
            float den = acc + sdec[rt] * qn;
            den += __shfl_xor(den, 1); den += __shfl_xor(den, 2); den += __shfl_xor(den, 4);
            if (seg == 0) sden[rt] = 1.f / fmaxf(fabsf(den), expf(-smt[rt]));
            __syncthreads();
        }
        f32x4 acc1[4][2];
        { bf16x8 bv[2][2];
#pragma unroll
          for (int i = 0; i < 2; ++i)
#pragma unroll
              for (int ks = 0; ks < 2; ++ks) bv[i][ks] = vfrag_tr(vN, 2 * wave + i, ks, fr, fq);
#pragma unroll
          for (int tt = 0; tt < 4; ++tt) { bf16x8 aq[4], as2[2]; float dec4[4];
#pragma unroll
              for (int ks = 0; ks < 4; ++ks) aq[ks] = *(const LAS bf16x8*)(q + (16 * tt + fr) * 136 + 32 * ks + 8 * fq);
#pragma unroll
              for (int ks = 0; ks < 2; ++ks) as2[ks] = *(const LAS bf16x8*)(Sb + (16 * tt + fr) * 72 + 32 * ks + 8 * fq);
#pragma unroll
              for (int r = 0; r < 4; ++r) dec4[r] = gla ? 1.f : sdec[16 * tt + 4 * fq + r];
#pragma unroll
              for (int i = 0; i < 2; ++i) { f32x4 x2 = {0.f, 0.f, 0.f, 0.f};
#pragma unroll
                  for (int ks = 0; ks < 4; ++ks) x2 = __builtin_amdgcn_mfma_f32_16x16x32_bf16(aq[ks], bcx[i][ks], x2, 0, 0, 0);
                  if (!gla) {
#pragma unroll
                      for (int r = 0; r < 4; ++r) x2[r] *= dec4[r]; }
#pragma unroll
                  for (int ks = 0; ks < 2; ++ks) x2 = __builtin_amdgcn_mfma_f32_16x16x32_bf16(as2[ks], bv[i][ks], x2, 0, 0, 0);
                  acc1[tt][i] = x2; }
              __builtin_amdgcn_sched_barrier(0); } }
        v4u gpre[4];
#pragma unroll
        for (int j = 0; j < 4; ++j) gpre[j] = *(const GAS v4u*)((const bf16*)(ws + WS_PROJ) + (t0 + rt) * NPROJ + (gla ? PC_GG : PC_MO) + h * 256 + 32 * seg + 8 * j);
        __syncthreads();
#pragma unroll
        for (int tt = 0; tt < 4; ++tt)
#pragma unroll
            for (int r = 0; r < 4; ++r) { const int t = 16 * tt + 4 * fq + r; const float dn = gla ? 1.f : sden[t];
#pragma unroll
                for (int i = 0; i < 2; ++i) hbuf[t * 260 + 16 * (2 * wave + i) + fr] = acc1[tt][i][r] * dn; }
        __syncthreads();
        { f32x4 hv[8]; float s1 = 0.f, s2 = 0.f;
#pragma unroll
          for (int j = 0; j < 8; ++j) { hv[j] = *(const LAS f32x4*)(hbuf + rt * 260 + 32 * seg + 4 * j); s1 += (hv[j].x + hv[j].y) + (hv[j].z + hv[j].w); }
          s1 += __shfl_xor(s1, 1); s1 += __shfl_xor(s1, 2); s1 += __shfl_xor(s1, 4);
          const float mean = gla ? 0.f : s1 * (1.f / 256.f);
#pragma unroll
          for (int j = 0; j < 8; ++j) { hv[j] = hv[j] - mean; s2 += (hv[j].x * hv[j].x + hv[j].y * hv[j].y) + (hv[j].z * hv[j].z + hv[j].w * hv[j].w); }
          s2 += __shfl_xor(s2, 1); s2 += __shfl_xor(s2, 2); s2 += __shfl_xor(s2, 4);
          const float rs = 1.f / sqrtf(s2 * (1.f / 256.f) + LN_EPS);
          const float* nw = (gla ? p.g_norm_w : p.m_norm_w) + h * 256 + 32 * seg;
          bf16* Y = (bf16*)(ws + (gla ? WS_YG : WS_YM)) + (t0 + rt) * 1024 + h * 256 + 32 * seg;
#pragma unroll
          for (int j = 0; j < 4; ++j) { float g8[8]; unpack8(gpre[j], g8);
              const f32x4 w0 = *(const f32x4*)(nw + 8 * j), w1 = *(const f32x4*)(nw + 8 * j + 4);
              const f32x4 o0 = hv[2 * j] * rs * w0, o1 = hv[2 * j + 1] * rs * w1;
              v4u w; w.x = pk2(o0.x * g8[0], o0.y * g8[1]); w.y = pk2(o0.z * g8[2], o0.w * g8[3]); w.z = pk2(o1.x * g8[4], o1.y * g8[5]); w.w = pk2(o1.z * g8[6], o1.w * g8[7]);
              *(GAS v4u*)(Y + 8 * j) = w; } }
        __syncthreads();
    }
}

__device__ __forceinline__ void ln_router_phase(const KP& p, LAS unsigned char* lds, gu32* ctl, int G, int vcu, int tid, int wave, int lane) {
    unsigned char* ws = p.ws;
    const bf16* MIX = (const bf16*)(ws + WS_PRE); bf16* X1 = (bf16*)(ws + WS_X1); unsigned char* X1F8 = ws + WS_X1F8; const bf16* WRT = (const bf16*)(ws + WS_WRT);
    int* SLOT = (int*)(ws + WS_SLOT); int* ASG_E = (int*)(ws + WS_ASG); int* ASG_R = ASG_E + T * 4; float* ASG_G = (float*)(ASG_R + T * 4);
    constexpr int XT_STRIDE = 2056;
    LAS bf16* xt = (LAS bf16*)lds; LAS float* part = (LAS float*)(lds + 65792); LAS int* ae = (LAS int*)(lds + 84224); LAS float* ag = (LAS float*)(lds + 84224 + 2048); LAS int* alr = (LAS int*)(lds + 84224 + 4096);
    LAS int* hist = (LAS int*)(lds + 90368); LAS int* basev = hist + 32;
    const int fr = lane & 15, fq = lane >> 4;
    if (tid < 32) hist[tid] = 0;
    bf16x8 bw[2][8];
#pragma unroll
    for (int ct = 0; ct < 2; ++ct)
#pragma unroll
        for (int ksl = 0; ksl < 8; ++ksl) bw[ct][ksl] = *(const GAS bf16x8*)(WRT + (size_t)(16 * ct + fr) * DM + 32 * (8 * wave + ksl) + 8 * fq);
    const float brt = p.b_router[lane & 31];
    for (int slab = vcu; slab < T / 128; slab += G) {
        const int m0 = slab * 128;
#pragma unroll 1
        for (int bt = 0; bt < 8; ++bt) {
#pragma unroll
            for (int i = 0; i < 2; ++i) { const int rl = 2 * wave + i; const int m = m0 + bt * 16 + rl;
                const GAS f32x4* xr = (const GAS f32x4*)(p.x + (size_t)m * DM) + lane; const GAS unsigned long long* mr = (const GAS unsigned long long*)(MIX + (size_t)m * DM) + lane;
                f32x4 v[8]; float s = 0.f;
#pragma unroll
                for (int j = 0; j < 8; ++j) { const f32x4 xv = xr[64 * j]; const unsigned long long w = mr[64 * j];
                    v[j].x = DN_ALPHA * xv.x + bf2f((unsigned)w & 0xffffu); v[j].y = DN_ALPHA * xv.y + bf2f(((unsigned)w) >> 16); v[j].z = DN_ALPHA * xv.z + bf2f((unsigned)(w >> 32) & 0xffffu); v[j].w = DN_ALPHA * xv.w + bf2f((unsigned)(w >> 48));
                    s += (v[j].x + v[j].y) + (v[j].z + v[j].w); }
                const float mean = wave_sum(s) * (1.f / DM); float s2 = 0.f;
#pragma unroll
                for (int j = 0; j < 8; ++j) { v[j] = v[j] - mean; s2 += (v[j].x * v[j].x + v[j].y * v[j].y) + (v[j].z * v[j].z + v[j].w * v[j].w); }
                const float rstd = 1.f / sqrtf(wave_sum(s2) * (1.f / DM) + LN_EPS);
                GAS unsigned long long* xo = (GAS unsigned long long*)(X1 + (size_t)m * DM) + lane; GAS unsigned* x8 = (GAS unsigned*)(X1F8 + (size_t)m * DM) + lane;
                LAS unsigned long long* xl = (LAS unsigned long long*)(xt + rl * XT_STRIDE) + lane;
#pragma unroll
                for (int j = 0; j < 8; ++j) { const f32x4 g = *((const GAS f32x4*)p.ln1_g + lane + 64 * j), bb = *((const GAS f32x4*)p.ln1_b + lane + 64 * j);
                    v[j] = v[j] * rstd * g + bb;
                    const unsigned long long pk = (unsigned long long)pk2(v[j].x, v[j].y) | ((unsigned long long)pk2(v[j].z, v[j].w) << 32); xo[64 * j] = pk;
                    xl[64 * j] = (unsigned long long)pkh2(v[j].x, v[j].y) | ((unsigned long long)pkh2(v[j].z, v[j].w) << 32);
                    x8[64 * j] = pk4_fp8(v[j].x * X8_SCALE, v[j].y * X8_SCALE, v[j].z * X8_SCALE, v[j].w * X8_SCALE); } }
            __syncthreads();
            { f32x4 a0 = {0.f, 0.f, 0.f, 0.f}, a1 = {0.f, 0.f, 0.f, 0.f};
#pragma unroll
              for (int ksl = 0; ksl < 8; ++ksl) { const bf16x8 af = *(const LAS bf16x8*)(xt + fr * XT_STRIDE + 32 * (8 * wave + ksl) + 8 * fq);
                  a0 = __builtin_amdgcn_mfma_f32_16x16x32_f16(__builtin_bit_cast(f16x8, af), __builtin_bit_cast(f16x8, bw[0][ksl]), a0, 0, 0, 0); a1 = __builtin_amdgcn_mfma_f32_16x16x32_f16(__builtin_bit_cast(f16x8, af), __builtin_bit_cast(f16x8, bw[1][ksl]), a1, 0, 0, 0); }
#pragma unroll
              for (int r = 0; r < 4; ++r) { part[wave * 512 + (4 * fq + r) * 32 + fr] = a0[r]; part[wave * 512 + (4 * fq + r) * 32 + 16 + fr] = a1[r]; } }
            __syncthreads();
            { float lgv = brt;
#pragma unroll
              for (int w = 0; w < 8; ++w) lgv += part[w * 512 + tid];
              const int myi = lane & 31; float val[4]; int sel[4]; float cur = lgv;
#pragma unroll
              for (int kk = 0; kk < 4; ++kk) { float bv = cur; int bi = myi;
#pragma unroll
                  for (int o = 1; o < 32; o <<= 1) { const float ov = __shfl_xor(bv, o); const int oi = __shfl_xor(bi, o); if (ov > bv || (ov == bv && oi < bi)) { bv = ov; bi = oi; } }
                  val[kk] = bv; sel[kk] = bi; if (myi == bi) cur = -INFINITY; }
              const float e1 = expf(val[1] - val[0]), e2 = expf(val[2] - val[0]), e3 = expf(val[3] - val[0]); const float inv = 1.f / (1.f + e1 + e2 + e3);
              if (myi < 4) { const int e = myi == 0 ? sel[0] : myi == 1 ? sel[1] : myi == 2 ? sel[2] : sel[3]; const float g = (myi == 0 ? 1.f : myi == 1 ? e1 : myi == 2 ? e2 : e3) * inv;
                  const int ai = (bt * 16 + (tid >> 5)) * 4 + myi;
                  ae[ai] = e; ag[ai] = g; alr[ai] = __hip_atomic_fetch_add(hist + e, 1, __ATOMIC_RELAXED, __HIP_MEMORY_SCOPE_WORKGROUP); } }
        }
        __syncthreads();
        if (tid < 32) { const int h = hist[tid]; basev[tid] = h > 0 ? (int)__hip_atomic_fetch_add(ctl + CW_CNT + 64 * tid, (unsigned)h, RLX_AGENT) : 0; hist[tid] = 0; }
        __syncthreads();
        { const int m = m0 + (tid >> 2), kk = tid & 3; const int e = ae[tid]; const int rank = basev[e] + alr[tid];
          SLOT[(size_t)e * T + rank] = m; ASG_E[m * 4 + kk] = e; ASG_R[m * 4 + kk] = rank; ASG_G[m * 4 + kk] = ag[tid]; }
        __syncthreads();
    }
}

__device__ __forceinline__ void final_phase(const KP& p, const LAS int* tst, int G, int vcu, int wave, int lane) {
    unsigned char* ws = p.ws;
    const bf16* X1 = (const bf16*)(ws + WS_X1); const unsigned char* OUTS = ws + WS_OUTS;
    const int* ASG_E = (const int*)(ws + WS_ASG); const int* ASG_R = ASG_E + T * 4; const float* ASG_G = (const float*)(ASG_R + T * 4);
    const int gw = vcu * NWAVES + wave, NGW = G * NWAVES;
    f32x4 lg[8], lb[8];
#pragma unroll
    for (int j = 0; j < 8; ++j) { lg[j] = *((const GAS f32x4*)p.ln2_g + lane + 64 * j); lb[j] = *((const GAS f32x4*)p.ln2_b + lane + 64 * j); }
    for (int m = gw; m < T; m += NGW) {
        f32x4 v[8]; const GAS unsigned long long* xr = (const GAS unsigned long long*)(X1 + (size_t)m * DM) + lane;
#pragma unroll
        for (int j = 0; j < 8; ++j) { const unsigned long long w = xr[64 * j];
            v[j].x = DN_ALPHA * bf2f((unsigned)w & 0xffffu); v[j].y = DN_ALPHA * bf2f(((unsigned)w) >> 16); v[j].z = DN_ALPHA * bf2f((unsigned)(w >> 32) & 0xffffu); v[j].w = DN_ALPHA * bf2f((unsigned)(w >> 48)); }
#pragma unroll
        for (int kk = 0; kk < 4; ++kk) { const int e = ASG_E[m * 4 + kk], rk = ASG_R[m * 4 + kk]; const float g = ASG_G[m * 4 + kk];
            const size_t row = (size_t)tst[e] * 256 + rk; const GAS unsigned* orow = (const GAS unsigned*)(OUTS + row * DM) + lane; const float gs = g * (1.f / O8_SCALE);
#pragma unroll
            for (int j = 0; j < 8; ++j) { const int w = (int)orow[64 * j];
                v[j].x += gs * __builtin_amdgcn_cvt_f32_fp8(w, 0); v[j].y += gs * __builtin_amdgcn_cvt_f32_fp8(w, 1); v[j].z += gs * __builtin_amdgcn_cvt_f32_fp8(w, 2); v[j].w += gs * __builtin_amdgcn_cvt_f32_fp8(w, 3); } }
        float s = 0.f;
#pragma unroll
        for (int j = 0; j < 8; ++j) s += (v[j].x + v[j].y) + (v[j].z + v[j].w);
        const float mean = wave_sum(s) * (1.f / DM); float s2 = 0.f;
#pragma unroll
        for (int j = 0; j < 8; ++j) { v[j] = v[j] - mean; s2 += (v[j].x * v[j].x + v[j].y * v[j].y) + (v[j].z * v[j].z + v[j].w * v[j].w); }
        const float rstd = 1.f / sqrtf(wave_sum(s2) * (1.f / DM) + LN_EPS);
        GAS f32x4* xo = (GAS f32x4*)(p.out + (size_t)m * DM) + lane;
#pragma unroll
        for (int j = 0; j < 8; ++j) xo[64 * j] = v[j] * rstd * lg[j] + lb[j];
    }
}

constexpr int N_PHASES = 11;
#ifndef NCONV_GROUPS
#define NCONV_GROUPS 4
#endif
#ifndef MK_ONE_LAUNCH
#define MK_ONE_LAUNCH 1
#endif
struct Args { const float* in[22]; float* out; unsigned char* ws; int ph_lo, ph_hi; };
__global__ void __launch_bounds__(NTHR, 2) fwd(Args args) {
    extern __shared__ __attribute__((aligned(16))) unsigned char lds_raw[];
    LAS unsigned char* lds = (LAS unsigned char*)lds_raw;
    volatile LAS unsigned* MISC = (volatile LAS unsigned*)(lds + MISC_OFF);
    const int tid = threadIdx.x, lane = tid & 63, wave = __builtin_amdgcn_readfirstlane(tid >> 6);
    const int G = gridDim.x; const int bx = blockIdx.x; const int vcu = (G % 8 == 0) ? (bx % 8) * (G / 8) + bx / 8 : bx;
    KP p; p.x = args.in[0]; p.w_in = args.in[1]; p.b_in = args.in[2]; p.conv_w = args.in[3]; p.conv_b = args.in[4]; p.w_gla = args.in[5]; p.b_gla = args.in[6]; p.m_norm_w = args.in[7]; p.g_norm_w = args.in[8];
    p.w_bm = args.in[9]; p.w_bg = args.in[10]; p.w_out = args.in[11]; p.ln1_g = args.in[12]; p.ln1_b = args.in[13]; p.w_router = args.in[14]; p.b_router = args.in[15]; p.w_gu = args.in[16]; p.b_gu = args.in[17];
    p.w_down = args.in[18]; p.b_down = args.in[19]; p.ln2_g = args.in[20]; p.ln2_b = args.in[21]; p.out = args.out; p.ws = args.ws;
    unsigned char* ws = args.ws;
    gu32* ctl = (gu32*)(ws + WS_CTL);
    for (int u = tid; u < (LDS_BYTES - LDSCTL_OFF) / 4; u += NTHR) ((LAS unsigned*)(lds + LDSCTL_OFF))[u] = 0u;
    __syncthreads();
    const int lo = args.ph_lo, hi = args.ph_hi;
    XcdBarrier bar; bar.bar = (unsigned*)(ctl + CW_BAR); bar.x = 0; bar.st = nullptr;
    if (hi - lo > 1) bar = xcd_barrier_post((unsigned*)(ctl + CW_BAR), MISC + 8);
#ifndef PHASE_MASK
#define PHASE_MASK 0xffffffffu
#endif
#define IN(k) (((PHASE_MASK >> (k)) & 1u) && lo <= (k) && (k) < hi)
#define SEAM(k) do { if (IN(k) && IN((k) + 1)) xcd_barrier(bar); } while (0)
    LAS int* tst = (LAS int*)(lds + TST_OFF);

    if (IN(0)) { p0_prologue(p, lds, G, vcu, wave, lane); } SEAM(0);
    if (IN(1)) {
        const int gi = bx >> 3; const bool conv = (G == 256) && (gi < NCONV_GROUPS);
        if (!conv) {
            const int Gg = (G == 256) ? 256 - 8 * NCONV_GROUPS : G; const int cg = (G == 256) ? (gi - NCONV_GROUPS) * 8 + (bx & 7) : bx;
            { pg8::Gemm g{(const pg8::bf16_t*)(ws + WS_XB), (const pg8::bf16_t*)(ws + WS_WIN), T, NP1, DM}; SubsetOrderBf S; S.init(T, N_BF_TILES * 256, Gg, cg);
              EpiProj E{(bf16*)(ws + WS_PROJ), (float*)(ws + WS_SMALL), (const float*)(ws + WS_BIAS1), 1.f};
              pg8::gemm_phase<EpiProj, SubsetOrderBf, true, true>(lds, g, S, E); }
            if (N_F8_TILES > 0) { pg8::Gemm8 g{ws + WS_XB8, ws + WS_WIN8, DM}; SubsetOrderF8 S; S.init(T, N_F8_TILES * 256, Gg, cg);
              EpiProj E{(bf16*)(ws + WS_PROJ), (float*)(ws + WS_SMALL), (const float*)(ws + WS_BIAS1), 1.f / (X8_SCALE * W8_SCALE)};
              pg8::gemm_phase_f8<EpiProj, SubsetOrderF8>(lds, g, S, E); }
        }
        moe_convert_queue(p, lds, ctl, wave, lane);
    } SEAM(1);
    if (IN(2)) { mixer_local_mlstm<0>(p, lds, bx, G, tid, lane, wave); mixer_local_gla(p, lds, bx, G, tid, lane, wave); } SEAM(2);
    if (IN(3)) { scan_phase(p, lds, G, tid); } SEAM(3);
    if (IN(4)) { mixer_out_phase<false>(p, lds, bx, G, tid, lane, wave); mixer_out_phase<true>(p, lds, bx, G, tid, lane, wave); } SEAM(4);
    if (IN(5)) {
        static_assert(WS_YG - WS_YM == (size_t)128 * 256 * 1024 * 2 && WS_WBG - WS_WBM == (size_t)8 * 256 * 1024 * 2, "pair offsets");
        pg8::Gemm g{(const pg8::bf16_t*)(ws + WS_YM), (const pg8::bf16_t*)(ws + WS_WBM), T, DM, 1024}; PairOrder S; S.init(T, DM, G, bx);
        EpiBranchFused E{(bf16*)(ws + WS_Z), ws + WS_GATES};
        pg8::gemm_phase<EpiBranchFused, PairOrder, true, true>(lds, g, S, E);
    } SEAM(5);
    if (IN(6)) {
        pg8::Gemm g{(const pg8::bf16_t*)(ws + WS_Z), (const pg8::bf16_t*)(ws + WS_WOUT), T, DM, DM}; pg8::StaticOrder S; S.init(T, DM, G, bx);
        EpiMix E{(bf16*)(ws + WS_PRE)};
        pg8::gemm_phase<EpiMix, pg8::StaticOrder, true, true>(lds, g, S, E);
    } SEAM(6);
    if (IN(7)) { ln_router_phase(p, lds, ctl, G, vcu, tid, wave, lane); } SEAM(7);
    if (IN(8)) {
        moe_tables(ctl, tst, tid);
        pg8::Gemm8 g{ws + WS_X1F8, ws + WS_WGU, DM}; MoeOrder S{tst, G, bx, 16, (const int*)(ws + WS_SLOT)};
        EpiSwiglu E{ws + WS_ACT, p.b_gu};
        pg8::gemm_phase_f8<EpiSwiglu, MoeOrder>(lds, g, S, E);
    } SEAM(8);
    if (IN(9)) {
        moe_tables(ctl, tst, tid);
        pg8::Gemm8 g{ws + WS_ACT, ws + WS_WD, DM}; MoeOrder S{tst, G, bx, 8, nullptr};
        EpiDown E{ws + WS_OUTS, p.b_down};
        pg8::gemm_phase_f8<EpiDown, MoeOrder>(lds, g, S, E);
    } SEAM(9);
    if (IN(10)) { moe_tables(ctl, tst, tid); final_phase(p, tst, G, vcu, wave, lane); }
#undef IN
#undef SEAM
}

#if defined(PROBE_GEMM1) || defined(PROBE_GEMM8)
struct FakeOrder { int n, c, amask, bmask;
    __device__ __forceinline__ bool next(int i, pg8::Unit& u) const { if (i >= n) return false; u.pm = (c >> 3) & amask; u.pn = c & bmask; return true; }
    __device__ __forceinline__ void a_ready(const pg8::Unit&) const {}
    __device__ __forceinline__ void done(const pg8::Unit&) const {} };
struct EpiDummy { static constexpr bool PERM = true, AFTER_DRAIN = false, CHAIN = false; bf16* O;
    __device__ __forceinline__ void operator()(const pg8::f32x4 (&acc)[2][2][4][2], const pg8::Unit& u, int wr, int wc, int fr, int fq) const {
        bf16* base = O + (size_t)blockIdx.x * 65536; const int row0 = wr * 64 + fr, col0 = wc * 32 + 8 * fq;
#pragma unroll
        for (int ai = 0; ai < 2; ++ai)
#pragma unroll
            for (int m = 0; m < 4; ++m)
#pragma unroll
                for (int bj = 0; bj < 2; ++bj) { const pg8::f32x4 v0 = acc[ai][bj][m][0], v1 = acc[ai][bj][m][1];
                    pg8::u32x4 w; w.x = pg8::cvt_pk_bf16(v0[0], v0[1]); w.y = pg8::cvt_pk_bf16(v0[2], v0[3]); w.z = pg8::cvt_pk_bf16(v1[0], v1[1]); w.w = pg8::cvt_pk_bf16(v1[2], v1[3]);
                    *(pg8::u32x4*)(base + (size_t)(row0 + ai * 128 + m * 16) * 256 + col0 + bj * 128) = w; } } };
#endif
#if defined(PROBE_GEMM8)
struct FakeOrder8 : FakeOrder { __device__ __forceinline__ unsigned a_row(const pg8::Unit& u, int r) const { return (unsigned)(u.pm * 256 + r); } };
#endif
#if defined(PROBE_VAR_OUT) || defined(PROBE_VAR_LOC) || defined(PROBE_GEMM1) || defined(PROBE_GEMM8)
__global__ void __launch_bounds__(NTHR, 2) fwd_var(Args args) {
    extern __shared__ __attribute__((aligned(16))) unsigned char lds_raw[];
    LAS unsigned char* lds = (LAS unsigned char*)lds_raw;
    const int tid = threadIdx.x, lane = tid & 63, wave = __builtin_amdgcn_readfirstlane(tid >> 6);
    const int G = gridDim.x; const int bx = blockIdx.x;
    KP p; p.x = args.in[0]; p.w_in = args.in[1]; p.b_in = args.in[2]; p.conv_w = args.in[3]; p.conv_b = args.in[4]; p.w_gla = args.in[5]; p.b_gla = args.in[6]; p.m_norm_w = args.in[7]; p.g_norm_w = args.in[8];
    p.w_bm = args.in[9]; p.w_bg = args.in[10]; p.w_out = args.in[11]; p.ln1_g = args.in[12]; p.ln1_b = args.in[13]; p.w_router = args.in[14]; p.b_router = args.in[15]; p.w_gu = args.in[16]; p.b_gu = args.in[17];
    p.w_down = args.in[18]; p.b_down = args.in[19]; p.ln2_g = args.in[20]; p.ln2_b = args.in[21]; p.out = args.out; p.ws = args.ws;
#if defined(PROBE_GEMM8)
    { unsigned char* ws = args.ws; pg8::Gemm8 g{ws + WS_ACT, ws + WS_WD, DM}; FakeOrder8 S; S.n = PROBE_GEMM8; S.c = bx; S.amask = PROBE_AMASK; S.bmask = PROBE_BMASK;
      EpiDummy E{(bf16*)(ws + WS_XS)}; pg8::gemm_phase_f8<EpiDummy, FakeOrder8>(lds, g, S, E); (void)tid; (void)lane; (void)wave; (void)p; }
#elif defined(PROBE_GEMM1)
    { unsigned char* ws = args.ws; pg8::Gemm g{(const pg8::bf16_t*)(ws + WS_XB), (const pg8::bf16_t*)(ws + WS_WIN), T, NP1, DM}; FakeOrder S{PROBE_GEMM1, bx, PROBE_AMASK, PROBE_BMASK};
      EpiDummy E{(bf16*)(ws + WS_T1)}; pg8::gemm_phase<EpiDummy, FakeOrder, true, true>(lds, g, S, E); (void)tid; (void)lane; (void)wave; (void)p; }
#elif defined(PROBE_VAR_OUT)
    mixer_out_phase<PROBE_VAR_GLA>(p, lds, bx, G, tid, lane, wave);
#else
    if (PROBE_VAR_GLA) mixer_local_gla(p, lds, bx, G, tid, lane, wave); else mixer_local_mlstm<PROBE_LOCX>(p, lds, bx, G, tid, lane, wave);
#endif
}
#endif
extern "C" void kernel_launch(void* const* d_in, const int* in_sizes, int n_in, void* d_out, int out_size, void* d_ws, size_t ws_size, hipStream_t stream) {
    static int grid = 0;
    if (grid == 0) {
        if (n_in != 22 || in_sizes[0] != T * DM || out_size != T * DM || ws_size < WS_END) { fprintf(stderr, "kernel_launch: unexpected problem (n_in %d, in0 %d, out %d, ws %zu < %zu); nothing launched\n", n_in, n_in > 0 ? in_sizes[0] : -1, out_size, ws_size, (size_t)WS_END); grid = -1; return; }
        int dev = 0, cus = 0, per_cu = 0;
        if (hipGetDevice(&dev) != hipSuccess || hipDeviceGetAttribute(&cus, hipDeviceAttributeMultiprocessorCount, dev) != hipSuccess) { grid = -1; return; }
        if (hipFuncSetAttribute((const void*)fwd, hipFuncAttributeMaxDynamicSharedMemorySize, LDS_BYTES) != hipSuccess) { fprintf(stderr, "kernel_launch: hipFuncSetAttribute failed\n"); grid = -1; return; }
        if (hipOccupancyMaxActiveBlocksPerMultiprocessor(&per_cu, (const void*)fwd, NTHR, LDS_BYTES) != hipSuccess || per_cu < 1) fprintf(stderr, "kernel_launch: occupancy query reports %d\n", per_cu);
        (void)hipGetLastError();
        grid = cus;
    }
    if (grid < 0) return;
    if (hipMemsetAsync((char*)d_ws + WS_CTL, 0, CTL_ZERO_BYTES, stream) != hipSuccess) return;
    Args a{};
    for (int i = 0; i < 22; ++i) a.in[i] = (const float*)d_in[i];
    a.out = (float*)d_out; a.ws = (unsigned char*)d_ws;
#if defined(PROBE_SEQ)
    { const int seq[] = {PROBE_SEQ}; for (unsigned i = 0; i < sizeof(seq) / sizeof(int); ++i) { a.ph_lo = seq[i]; a.ph_hi = seq[i] + 1;
#if defined(PROBE_VAR_OUT) || defined(PROBE_VAR_LOC) || defined(PROBE_GEMM1) || defined(PROBE_GEMM8)
        if (seq[i] == 100) { a.ph_lo = 0; a.ph_hi = 0; hipFuncSetAttribute((const void*)fwd_var, hipFuncAttributeMaxDynamicSharedMemorySize, LDS_BYTES); hipLaunchKernelGGL(fwd_var, dim3(grid), dim3(NTHR), LDS_BYTES, stream, a); continue; }
#endif
        hipLaunchKernelGGL(fwd, dim3(grid), dim3(NTHR), LDS_BYTES, stream, a); } }
#elif MK_ONE_LAUNCH
    a.ph_lo = 0; a.ph_hi = N_PHASES;
    hipLaunchKernelGGL(fwd, dim3(grid), dim3(NTHR), LDS_BYTES, stream, a);
#else
    for (int ph = 0; ph < N_PHASES; ++ph) { a.ph_lo = ph; a.ph_hi = ph + 1; hipLaunchKernelGGL(fwd, dim3(grid), dim3(NTHR), LDS_BYTES, stream, a); }
#endif
}
```

```cpp
#include <hip/hip_runtime.h>
#include <cstdio>
#include <cstdint>
#include <cmath>
namespace pg8 {
#define PG8_LAS __attribute__((address_space(3)))
typedef unsigned short bf16_t;
typedef short bf16x8 __attribute__((ext_vector_type(8)));
typedef float f32x4 __attribute__((ext_vector_type(4)));
typedef unsigned u32x4 __attribute__((ext_vector_type(4)));
constexpr int BM = 256, BK = 64, HALF = 128, HTB = HALF * BK * 2  , STAGE_BYTES = 8 * HTB, NXCD = 8, WGM = 8;

__host__ __device__ __forceinline__ int lds_byte(int r, int c) { const int st = (r >> 4) * 2 + (c >> 5), rr = r & 15, cc = c & 31, ob = rr * 64 + cc * 2; return st * 1024 + (ob ^ (((ob >> 9) & 1) << 5)); }
__host__ __device__ __forceinline__ void stage_rc(int b, int& R, int& C) { const int st = b / 1024, sb = b % 1024, swz = sb ^ (((sb >> 9) & 1) << 5); R = (st >> 1) * 16 + swz / 64; C = (st & 1) * 32 + (swz % 64) / 2; }
__host__ __device__ __forceinline__ int perm32(int rho) { const int n = rho >> 4, i = rho & 15; return 8 * (i >> 2) + 4 * n + (i & 3); }

struct Unit { int pm, pn; };
struct Gemm { const bf16_t* A; const bf16_t* Bt; int M, N, K; };

struct StaticOrder {
    int nM, nN, nwg, G, c;
    __host__ __device__ void init(int M, int N, int G_, int c_) { nM = M / BM; nN = N / BM; nwg = nM * nN; G = G_; c = c_; }
    __host__ __device__ bool next(int i, Unit& u) const {
        const long L = (long)i * G + c; if (L >= nwg) return false;
        int wgid = (int)L; { const int q = nwg / NXCD, r = nwg % NXCD, xcd = wgid % NXCD, off = wgid / NXCD; wgid = (xcd < r ? xcd * (q + 1) : r * (q + 1) + (xcd - r) * q) + off; }
        const int nig = WGM * nN, gid = wgid / nig, fm = gid * WGM, gsz = (nM - fm) < WGM ? (nM - fm) : WGM;
        u.pm = fm + ((wgid % nig) % gsz); u.pn = (wgid % nig) / gsz; return true;
    }
    __device__ __forceinline__ void a_ready(const Unit&) const {}
    __device__ __forceinline__ void done(const Unit&) const {}
};

__device__ __forceinline__ unsigned cvt_pk_bf16(float lo, float hi) { unsigned r; asm volatile("v_cvt_pk_bf16_f32 %0, %1, %2" : "=v"(r) : "v"(lo), "v"(hi)); return r; }
typedef float f32x2 __attribute__((ext_vector_type(2)));
template <class Epi, class Sched, bool ALIGN_EPI = false, bool SP2 = false>
__device__ __forceinline__ void gemm_phase(PG8_LAS unsigned char* lds, const Gemm g, const Sched& S, const Epi& E) {
    const int tid = threadIdx.x, wid = __builtin_amdgcn_readfirstlane(tid >> 6), lane = tid & 63, wr = wid >> 2, wc = wid & 3, fr = lane & 15, fq = lane >> 4;
    const int K = g.K, nt = K / BK;
    unsigned voffA[2], voffB[2];
#pragma unroll
    for (int i = 0; i < 2; ++i) { int R, C; stage_rc(tid * 16 + i * 8192, R, C); const int Rb = Epi::PERM ? ((R & ~31) + perm32(R & 31)) : R;
        voffA[i] = (unsigned)(R * K + C) * 2u; voffB[i] = (unsigned)(Rb * K + C) * 2u; }
    const size_t kstep = (size_t)(BK * 2);
    const size_t hstep = (size_t)HALF * K * 2;
    const size_t tstep = 2 * hstep;
    const unsigned ldsw = (unsigned)wid * 1024u;
    const int aoff = lds_byte(wr * 64 + fr, fq * 8), boff = lds_byte(wc * 32 + fr, fq * 8);
#define PG8_SA(b, h) (((b) * 2 + (h)) * HTB)
#define PG8_SB(b, h) ((4 + (b) * 2 + (h)) * HTB)
#define PG8_STAGE(bufoff, gbase, voff) do { _Pragma("unroll") for (int _i = 0; _i < 2; ++_i) \
        __builtin_amdgcn_global_load_lds((const unsigned*)((const char*)(gbase) + (voff)[_i]), (PG8_LAS unsigned*)(lds + (bufoff) + ldsw + _i * 8192), 16, 0, 0); } while (0)
#define PG8_LDA(dst, b, h) do { _Pragma("unroll") for (int m = 0; m < 4; ++m) _Pragma("unroll") for (int k = 0; k < 2; ++k) dst[m][k] = *(const PG8_LAS bf16x8*)(lds + PG8_SA(b, h) + aoff + m * 2048 + k * 1024); } while (0)
#define PG8_LDB(dst, b, h) do { _Pragma("unroll") for (int n = 0; n < 2; ++n) _Pragma("unroll") for (int k = 0; k < 2; ++k) dst[n][k] = *(const PG8_LAS bf16x8*)(lds + PG8_SB(b, h) + boff + n * 2048 + k * 1024); } while (0)
#define PG8_MMA(ai, bj, At, Bt) do { __builtin_amdgcn_s_setprio(1); _Pragma("unroll") for (int m = 0; m < 4; ++m) _Pragma("unroll") for (int n = 0; n < 2; ++n) _Pragma("unroll") for (int k = 0; k < 2; ++k) \
        acc[ai][bj][m][n] = __builtin_amdgcn_mfma_f32_16x16x32_bf16(Bt[n][k], At[m][k], acc[ai][bj][m][n], 0, 0, 0); __builtin_amdgcn_s_setprio(0); } while (0)
#define PG8_WAIT_V(n) asm volatile("s_waitcnt vmcnt(" #n ")" ::: "memory")
#define PG8_WAIT_L(n) asm volatile("s_waitcnt lgkmcnt(" #n ")" ::: "memory")
#define PG8_BAR __builtin_amdgcn_s_barrier()
#define PG8_SCHED __builtin_amdgcn_sched_barrier(0)
    Unit cur, nxt; int ui = 0;
    if (!S.next(0, cur)) return;
    f32x4 acc[2][2][4][2];
#pragma unroll
    for (int a = 0; a < 2; ++a)
#pragma unroll
        for (int b = 0; b < 2; ++b)
#pragma unroll
            for (int m = 0; m < 4; ++m)
#pragma unroll
                for (int n = 0; n < 2; ++n) acc[a][b][m][n] = (f32x4){0.f, 0.f, 0.f, 0.f};
    bf16x8 At[4][2], B0[2][2], B1[2][2];
    const char* cA = (const char*)g.A + (size_t)cur.pm * tstep; const char* cB = (const char*)g.Bt + (size_t)cur.pn * tstep;
    S.a_ready(cur);
    if constexpr (SP2) {
        PG8_STAGE(PG8_SB(0, 0), cB, voffB); PG8_STAGE(PG8_SB(0, 1), cB + hstep, voffB); PG8_STAGE(PG8_SA(0, 0), cA, voffA); PG8_STAGE(PG8_SA(0, 1), cA + hstep, voffA);
        if (wr == 1) PG8_BAR;
        PG8_WAIT_V(2); PG8_BAR;
        PG8_STAGE(PG8_SB(1, 0), cB + kstep, voffB); PG8_STAGE(PG8_SA(1, 0), cA + kstep, voffA); PG8_STAGE(PG8_SB(1, 1), cB + hstep + kstep, voffB);
        PG8_WAIT_V(6); PG8_BAR;
    } else {
        PG8_STAGE(PG8_SB(0, 0), cB, voffB); PG8_STAGE(PG8_SA(0, 0), cA, voffA); PG8_STAGE(PG8_SB(0, 1), cB + hstep, voffB); PG8_STAGE(PG8_SA(0, 1), cA + hstep, voffA);
        if (wr == 1) PG8_BAR;
        PG8_WAIT_V(4); PG8_BAR;
        PG8_STAGE(PG8_SB(1, 0), cB + kstep, voffB); PG8_STAGE(PG8_SA(1, 0), cA + kstep, voffA); PG8_STAGE(PG8_SB(1, 1), cB + hstep + kstep, voffB);
        PG8_WAIT_V(6); PG8_BAR;
    }
    for (;;) {
        const bool has_next = S.next(ui + 1, nxt);
        const char* nA = has_next ? (const char*)g.A + (size_t)nxt.pm * tstep : cA; const char* nB = has_next ? (const char*)g.Bt + (size_t)nxt.pn * tstep : cB;
        for (int t = 0; t < nt; t += 2) {
            const bool last = (t == nt - 2);
            const char* a1 = cA + (size_t)(t + 1) * kstep;
            const char* a2 = last ? nA : cA + (size_t)(t + 2) * kstep; const char* b2 = last ? nB : cB + (size_t)(t + 2) * kstep;
            const char* a3 = a2 + kstep; const char* b3 = b2 + kstep;
            if (last && has_next) S.a_ready(nxt);
            if constexpr (SP2) {
            PG8_LDB(B0, 0, 0); PG8_LDB(B1, 0, 1); PG8_SCHED; PG8_LDA(At, 0, 0); PG8_STAGE(PG8_SA(1, 1), a1 + hstep, voffA);
            PG8_WAIT_V(8); PG8_WAIT_L(0); PG8_BAR; PG8_MMA(0, 0, At, B0); PG8_MMA(0, 1, At, B1); PG8_BAR; PG8_SCHED;
            PG8_LDA(At, 0, 1); PG8_STAGE(PG8_SB(0, 0), b2, voffB); PG8_STAGE(PG8_SB(0, 1), b2 + hstep, voffB); PG8_STAGE(PG8_SA(0, 0), a2, voffA);
            PG8_WAIT_V(8); PG8_WAIT_L(0); PG8_BAR; PG8_MMA(1, 0, At, B0); PG8_MMA(1, 1, At, B1); PG8_BAR; PG8_SCHED;
            PG8_LDB(B0, 1, 0); PG8_LDB(B1, 1, 1); PG8_SCHED; PG8_LDA(At, 1, 0); PG8_STAGE(PG8_SA(0, 1), a2 + hstep, voffA);
            PG8_WAIT_V(8); PG8_WAIT_L(0); PG8_BAR; PG8_MMA(0, 0, At, B0); PG8_MMA(0, 1, At, B1); PG8_BAR; PG8_SCHED;
            PG8_LDA(At, 1, 1); PG8_STAGE(PG8_SB(1, 0), b3, voffB); PG8_STAGE(PG8_SB(1, 1), b3 + hstep, voffB); PG8_STAGE(PG8_SA(1, 0), a3, voffA);
            PG8_WAIT_V(8); PG8_WAIT_L(0); PG8_BAR; PG8_MMA(1, 0, At, B0); PG8_MMA(1, 1, At, B1); PG8_BAR; PG8_SCHED;
            } else {
            PG8_LDB(B0, 0, 0); PG8_SCHED; PG8_LDA(At, 0, 0); PG8_STAGE(PG8_SA(1, 1), a1 + hstep, voffA);
            PG8_WAIT_L(8); PG8_BAR; PG8_WAIT_L(0); PG8_MMA(0, 0, At, B0); PG8_BAR; PG8_SCHED;
            PG8_LDB(B1, 0, 1); PG8_STAGE(PG8_SB(0, 0), b2, voffB);
            PG8_BAR; PG8_WAIT_L(0); PG8_MMA(0, 1, At, B1); PG8_BAR;
            PG8_LDA(At, 0, 1); PG8_STAGE(PG8_SA(0, 0), a2, voffA);
            PG8_BAR; PG8_WAIT_L(0); PG8_MMA(1, 0, At, B0); PG8_BAR; PG8_SCHED;
            PG8_STAGE(PG8_SB(0, 1), b2 + hstep, voffB);
            PG8_WAIT_V(6); PG8_BAR; PG8_MMA(1, 1, At, B1); PG8_BAR;
            PG8_LDB(B0, 1, 0); PG8_SCHED; PG8_LDA(At, 1, 0); PG8_STAGE(PG8_SA(0, 1), a2 + hstep, voffA);
            PG8_WAIT_L(8); PG8_BAR; PG8_WAIT_L(0); PG8_MMA(0, 0, At, B0); PG8_BAR; PG8_SCHED;
            PG8_LDB(B1, 1, 1); PG8_STAGE(PG8_SB(1, 0), b3, voffB);
            PG8_BAR; PG8_WAIT_L(0); PG8_MMA(0, 1, At, B1); PG8_BAR;
            PG8_LDA(At, 1, 1); PG8_STAGE(PG8_SA(1, 0), a3, voffA);
            PG8_BAR; PG8_WAIT_L(0); PG8_MMA(1, 0, At, B0); PG8_BAR; PG8_SCHED;
            PG8_STAGE(PG8_SB(1, 1), b3 + hstep, voffB);
            PG8_WAIT_V(6); PG8_BAR; PG8_MMA(1, 1, At, B1); PG8_BAR;
            }
        }
        if constexpr (ALIGN_EPI) { if (wr == 0) PG8_BAR; }
        bool keep_acc = false;
        if constexpr (Epi::CHAIN) { keep_acc = E.chain(acc, cur, wr, wc, fr, fq); S.done(cur); }
        else if constexpr (!Epi::AFTER_DRAIN) { E(acc, cur, wr, wc, fr, fq); S.done(cur); }
        if (!has_next) break;
        if (!keep_acc)
#pragma unroll
        for (int a = 0; a < 2; ++a)
#pragma unroll
            for (int b = 0; b < 2; ++b)
#pragma unroll
                for (int m = 0; m < 4; ++m)
#pragma unroll
                    for (int n = 0; n < 2; ++n) acc[a][b][m][n] = (f32x4){0.f, 0.f, 0.f, 0.f};
        cur = nxt; cA = nA; cB = nB; ++ui;
        if constexpr (ALIGN_EPI) { if (wr == 1) PG8_BAR; }
    }
    PG8_WAIT_V(0);
    if constexpr (!ALIGN_EPI) { if (wr == 0) PG8_BAR; }
    PG8_BAR;
    if constexpr (Epi::AFTER_DRAIN) { E.fused(acc, cur, wr, wc, fr, fq, lds, wid, lane); S.done(cur); }
#undef PG8_SA
#undef PG8_SB
#undef PG8_STAGE
#undef PG8_LDA
#undef PG8_LDB
#undef PG8_MMA
#undef PG8_WAIT_V
#undef PG8_WAIT_L
#undef PG8_BAR
#undef PG8_SCHED
}
}
namespace pg8 {
typedef int i32x4v __attribute__((ext_vector_type(4)));
typedef int i32x8v __attribute__((ext_vector_type(8)));
struct Gemm8 { const unsigned char* A; const unsigned char* Bt; int K; };
template <class Epi, class Sched>
__device__ __forceinline__ void gemm_phase_f8(PG8_LAS unsigned char* lds, const Gemm8 g, const Sched& S, const Epi& E) {
    const int tid = threadIdx.x, wid = __builtin_amdgcn_readfirstlane(tid >> 6), lane = tid & 63, wr = wid >> 2, wc = wid & 3, fr = lane & 15, fq = lane >> 4;
    const int K = g.K, nt = K / 128;
    unsigned voffB[2];
#pragma unroll
    for (int i = 0; i < 2; ++i) { int R, C; stage_rc(tid * 16 + i * 8192, R, C); const int Rb = Epi::PERM ? ((R & ~31) + perm32(R & 31)) : R;
        voffB[i] = (unsigned)(Rb * K + C * 2); }
    PG8_LAS u32x4* nxslot = (PG8_LAS u32x4*)(lds + 133120) + tid;
    const size_t kstep = 128;
    const size_t hstep = (size_t)HALF * K;
    const size_t tstep = 2 * hstep;
    const unsigned ldsw = (unsigned)wid * 1024u;
    const int x16 = (fq & 1) * 16;
    const int aoff = lds_byte(wr * 64 + fr, fq * 16) + x16, boff = lds_byte(wc * 32 + fr, fq * 16) + x16;
    const int aoff2 = aoff + 16 - 2 * x16, boff2 = boff + 16 - 2 * x16;
#define F8_SA(b, h) (((b) * 2 + (h)) * HTB)
#define F8_SB(b, h) ((4 + (b) * 2 + (h)) * HTB)
#define F8_STAGE(bufoff, gbase, voff) do { _Pragma("unroll") for (int _i = 0; _i < 2; ++_i) \
        __builtin_amdgcn_global_load_lds((const unsigned*)((const char*)(gbase) + (voff)[_i]), (PG8_LAS unsigned*)(lds + (bufoff) + ldsw + _i * 8192), 16, 0, 0); } while (0)
#define F8_LD(dst, off, off2) do { const i32x4v _lo = *(const PG8_LAS i32x4v*)(lds + (off)), _hi = *(const PG8_LAS i32x4v*)(lds + (off2)); dst = __builtin_shufflevector(_lo, _hi, 0, 1, 2, 3, 4, 5, 6, 7); } while (0)
#define F8_LDA(dst, b, h) do { _Pragma("unroll") for (int m = 0; m < 4; ++m) F8_LD(dst[m], F8_SA(b, h) + aoff + m * 2048, F8_SA(b, h) + aoff2 + m * 2048); } while (0)
#define F8_LDB(dst, b, h) do { _Pragma("unroll") for (int n = 0; n < 2; ++n) F8_LD(dst[n], F8_SB(b, h) + boff + n * 2048, F8_SB(b, h) + boff2 + n * 2048); } while (0)
#define F8_MMA(ai, bj, At, Bt) do { __builtin_amdgcn_s_setprio(1); _Pragma("unroll") for (int m = 0; m < 4; ++m) _Pragma("unroll") for (int n = 0; n < 2; ++n) \
        acc[ai][bj][m][n] = __builtin_amdgcn_mfma_scale_f32_16x16x128_f8f6f4(Bt[n], At[m], acc[ai][bj][m][n], 0, 0, 0, 0, 0, 0); __builtin_amdgcn_s_setprio(0); } while (0)
#define F8_WAIT_V(n) asm volatile("s_waitcnt vmcnt(" #n ")" ::: "memory")
#define F8_WAIT_L(n) asm volatile("s_waitcnt lgkmcnt(" #n ")" ::: "memory")
#define F8_BAR __builtin_amdgcn_s_barrier()
#define F8_SCHED __builtin_amdgcn_sched_barrier(0)
#define F8_ROWS(dst, u) do { int _tz = threadIdx.x; asm volatile("" : "+v"(_tz)); _Pragma("unroll") for (int _i = 0; _i < 2; ++_i) { int _R, _C; stage_rc(_tz * 16 + _i * 8192, _R, _C); \
        _Pragma("unroll") for (int _h = 0; _h < 2; ++_h) dst[_h][_i] = S.a_row(u, _h * 128 + _R) * (unsigned)K + (unsigned)(_C * 2); } } while (0)
    Unit cur, nxt; int ui = 0;
    if (!S.next(0, cur)) return;
    f32x4 acc[2][2][4][2];
#pragma unroll
    for (int a = 0; a < 2; ++a)
#pragma unroll
        for (int b = 0; b < 2; ++b)
#pragma unroll
            for (int m = 0; m < 4; ++m)
#pragma unroll
                for (int n = 0; n < 2; ++n) acc[a][b][m][n] = (f32x4){0.f, 0.f, 0.f, 0.f};
    i32x8v At[4], B0[2], B1[2];
    PG8_LAS float* epad = (PG8_LAS float*)(lds + 141312 + wid * 256);
    unsigned curA[2][2];
    F8_ROWS(curA, cur);
    const char* gA = (const char*)g.A;
    const char* cB = (const char*)g.Bt + (size_t)cur.pn * tstep;
    S.a_ready(cur);
    F8_STAGE(F8_SB(0, 0), cB, voffB); F8_STAGE(F8_SB(0, 1), cB + hstep, voffB); F8_STAGE(F8_SA(0, 0), gA, curA[0]); F8_STAGE(F8_SA(0, 1), gA, curA[1]);
    if (wr == 1) F8_BAR;
    F8_WAIT_V(2); F8_BAR;
    F8_STAGE(F8_SB(1, 0), cB + kstep, voffB); F8_STAGE(F8_SA(1, 0), gA + kstep, curA[0]); F8_STAGE(F8_SB(1, 1), cB + hstep + kstep, voffB);
    F8_WAIT_V(6); F8_BAR;
    for (;;) {
        const bool has_next = S.next(ui + 1, nxt);
        { unsigned nx[2][2];
          if (has_next) { F8_ROWS(nx, nxt); } else { nx[0][0] = curA[0][0]; nx[0][1] = curA[0][1]; nx[1][0] = curA[1][0]; nx[1][1] = curA[1][1]; }
          *nxslot = (u32x4){nx[0][0], nx[0][1], nx[1][0], nx[1][1]}; }
        const char* nB = has_next ? (const char*)g.Bt + (size_t)nxt.pn * tstep : cB;
#pragma unroll 1
        for (int t = 0; t < nt; t += 2) {
            const bool last = (t == nt - 2);
            const char* a1 = gA + (size_t)(t + 1) * kstep;
            const char* a2 = last ? gA : gA + (size_t)(t + 2) * kstep; const char* b2 = last ? nB : cB + (size_t)(t + 2) * kstep;
            const char* a3 = a2 + kstep; const char* b3 = b2 + kstep;
            if (last && has_next) S.a_ready(nxt);
            if constexpr (Epi::HAS_PRE) { if (last) { E.prefetch(epad, cur, wc, lane); F8_SCHED; } }
            F8_LDB(B0, 0, 0); F8_LDB(B1, 0, 1); F8_SCHED; F8_LDA(At, 0, 0); F8_STAGE(F8_SA(1, 1), a1, curA[1]);
            if (last) { const u32x4 nv = *nxslot; curA[0][0] = nv.x; curA[0][1] = nv.y; curA[1][0] = nv.z; curA[1][1] = nv.w; }
            F8_WAIT_V(8); F8_WAIT_L(0); F8_BAR; F8_MMA(0, 0, At, B0); F8_MMA(0, 1, At, B1); F8_BAR; F8_SCHED;
            F8_LDA(At, 0, 1); F8_STAGE(F8_SB(0, 0), b2, voffB); F8_STAGE(F8_SB(0, 1), b2 + hstep, voffB); F8_STAGE(F8_SA(0, 0), a2, curA[0]);
            F8_WAIT_V(8); F8_WAIT_L(0); F8_BAR; F8_MMA(1, 0, At, B0); F8_MMA(1, 1, At, B1); F8_BAR; F8_SCHED;
            F8_LDB(B0, 1, 0); F8_LDB(B1, 1, 1); F8_SCHED; F8_LDA(At, 1, 0); F8_STAGE(F8_SA(0, 1), a2, curA[1]);
            F8_WAIT_V(8); F8_WAIT_L(0); F8_BAR; F8_MMA(0, 0, At, B0); F8_MMA(0, 1, At, B1); F8_BAR; F8_SCHED;
            F8_LDA(At, 1, 1); F8_STAGE(F8_SB(1, 0), b3, voffB); F8_STAGE(F8_SB(1, 1), b3 + hstep, voffB); F8_STAGE(F8_SA(1, 0), a3, curA[0]);
            F8_WAIT_V(8); F8_WAIT_L(0); F8_BAR; F8_MMA(1, 0, At, B0); F8_MMA(1, 1, At, B1); F8_BAR; F8_SCHED;
        }
        if (wr == 0) F8_BAR;
        bool keep_acc = false;
        if constexpr (Epi::CHAIN) { keep_acc = E.chain(acc, cur, wr, wc, fr, fq); S.done(cur); } else if constexpr (Epi::HAS_PRE) { E(acc, cur, wr, wc, fr, fq, epad); S.done(cur); } else { E(acc, cur, wr, wc, fr, fq); S.done(cur); }
        if (!has_next) break;
        if (!keep_acc)
#pragma unroll
        for (int a = 0; a < 2; ++a)
#pragma unroll
            for (int b = 0; b < 2; ++b)
#pragma unroll
                for (int m = 0; m < 4; ++m)
#pragma unroll
                    for (int n = 0; n < 2; ++n) acc[a][b][m][n] = (f32x4){0.f, 0.f, 0.f, 0.f};
        cur = nxt; cB = nB; ++ui;
        if (wr == 1) F8_BAR;
    }
    F8_WAIT_V(0);
    F8_BAR;
#undef F8_SA
#undef F8_SB
#undef F8_STAGE
#undef F8_LD
#undef F8_LDA
#undef F8_LDB
#undef F8_MMA
#undef F8_WAIT_V
#undef F8_WAIT_L
#undef F8_BAR
#undef F8_SCHED
#undef F8_ROWS
}
}
#define GAS __attribute__((address_space(1)))
#define LAS __attribute__((address_space(3)))
typedef unsigned short bf16;
typedef unsigned v4u __attribute__((ext_vector_type(4)));
typedef float f32x4 __attribute__((ext_vector_type(4)));
typedef short bf16x8 __attribute__((ext_vector_type(8)));
typedef GAS unsigned gu32;
typedef GAS unsigned long long gu64;
#define RLX_AGENT __ATOMIC_RELAXED, __HIP_MEMORY_SCOPE_AGENT
#define LDS_WAIT() asm volatile("s_waitcnt lgkmcnt(0)" ::: "memory")
#define VM_WAIT() asm volatile("s_waitcnt vmcnt(0)" ::: "memory")
__device__ __forceinline__ unsigned long long rt() { return __builtin_amdgcn_s_memrealtime(); }
__device__ __forceinline__ unsigned f2bf(float f) { unsigned u = __builtin_bit_cast(unsigned, f); return (u + 0x7fffu + ((u >> 16) & 1u)) >> 16; }
__device__ __forceinline__ unsigned pk2(float lo, float hi) { return f2bf(lo) | (f2bf(hi) << 16); }

#define XB_TMO      128
#define XB_XCNT(j)  (256  + 64 * (j))
#define XB_XSUB(j)  (1280 + 64 * (j))
#define XB_XGEN(j)  (2304 + 64 * (j))
#define XB_TOP      3328
#define XB_TOPGEN   3392
#define XCD_BAR_WORDS 3456
#define XB_SPIN_CAP (1u << 18)

__device__ __forceinline__ unsigned xb_ld(unsigned* p)              { return __hip_atomic_load(p, __ATOMIC_RELAXED, __HIP_MEMORY_SCOPE_AGENT); }
__device__ __forceinline__ unsigned xb_add(unsigned* p, unsigned v) { return __hip_atomic_fetch_add(p, v, __ATOMIC_RELAXED, __HIP_MEMORY_SCOPE_AGENT); }
__device__ __forceinline__ unsigned xb_xcc_id() { return (unsigned)__builtin_amdgcn_s_getreg((3 << 11) | 20) & 0xFu; }
#define XB_SPIN(cond, bar) do { unsigned _sp = 0; while (cond) { __builtin_amdgcn_s_sleep(1); \
    if ((++_sp & 255u) == 0u) { if (xb_ld(&(bar)[XB_TMO])) break; if (_sp > XB_SPIN_CAP) { atomicAdd(&(bar)[XB_TMO], 1u); break; } } } } while (0)

struct XcdBarrier {
    unsigned* bar; unsigned x;
    volatile LAS unsigned* st;
};

__device__ __forceinline__ XcdBarrier xcd_barrier_post(unsigned* bar, volatile LAS unsigned* st) {
    XcdBarrier b; b.bar = bar; b.x = xb_xcc_id(); b.st = st;
    if (threadIdx.x == 0) (void)xb_add(&bar[XB_XCNT(b.x)], 1u);
    return b;
}
__device__ __forceinline__ void xcd_barrier_complete(unsigned* bar, unsigned x, unsigned& nloc, unsigned& nx) {
    const unsigned G = gridDim.x * gridDim.y * gridDim.z;
    unsigned sum, cnt, mine, sp = 0u;
    for (;;) {
        sum = 0u; cnt = 0u; mine = 0u;
#pragma unroll
        for (unsigned j = 0; j < 16; ++j) { const unsigned c = xb_ld(&bar[XB_XCNT(j)]); sum += c; cnt += (c > 0u) ? 1u : 0u; mine = (j == x) ? c : mine; }
        if (sum == G) break;
        __builtin_amdgcn_s_sleep(1);
        if ((++sp & 255u) == 0u) { if (xb_ld(&bar[XB_TMO])) break; if (sp > XB_SPIN_CAP) { atomicAdd(&bar[XB_TMO], 1u); break; } }
    }
    nloc = mine > 0u ? mine : 1u; nx = cnt > 0u ? cnt : 1u;
}

__device__ __forceinline__ void xcd_barrier(const XcdBarrier& b) {
    asm volatile("s_waitcnt vmcnt(0)" ::: "memory");
    __syncthreads();
    if (threadIdx.x == 0) {
        unsigned* bar = b.bar;
        __builtin_amdgcn_s_waitcnt(0);
        unsigned nloc = b.st[0], nx = b.st[1];
        if (nloc == 0u) { xcd_barrier_complete(bar, b.x, nloc, nx); b.st[0] = nloc; b.st[1] = nx; }
        const unsigned old = xb_add(&bar[XB_XSUB(b.x)], 1u);
        const unsigned gen = old / nloc;
        if (old + 1u == (gen + 1u) * nloc) {
            __builtin_amdgcn_fence(__ATOMIC_RELEASE, "agent");
            asm volatile("s_waitcnt vmcnt(0)" ::: "memory");
            const unsigned og = xb_add(&bar[XB_TOP], 1u);
            const unsigned tg = og / nx;
            if (og + 1u == (tg + 1u) * nx) xb_add(&bar[XB_TOPGEN], 1u);
            else XB_SPIN(xb_ld(&bar[XB_TOPGEN]) == tg, bar);
            __builtin_amdgcn_fence(__ATOMIC_ACQUIRE, "agent");
            xb_add(&bar[XB_XGEN(b.x)], 1u);
            asm volatile("s_waitcnt vmcnt(0)" ::: "memory");
        } else {
            XB_SPIN(xb_ld(&bar[XB_XGEN(b.x)]) == gen, bar);
            __builtin_amdgcn_fence(__ATOMIC_ACQUIRE, "agent");
            asm volatile("s_waitcnt vmcnt(0)" ::: "memory");
        }
    }
    __syncthreads();
}

constexpr int NWAVES = 8, NTHR = NWAVES * 64;
constexpr int BATCH = 8, SEQ = 4096, DM = 2048, T = BATCH * SEQ;
constexpr int NH = 4, DK = 128, DV = 256, CH = 64, NC = SEQ / CH, NBH = BATCH * NH, NCHUNK = NBH * NC;
constexpr int D_IN = 10264, NP1 = 10496, NPROJ = 10240;
constexpr int NE = 32, TOPK = 4, DFF = 2048;
constexpr int P_MAX = T * TOPK + NE * 256;
constexpr float LN_EPS = 1e-5f;
constexpr float DN_ALPHA = 1.18920711500272f;
constexpr float RSQRT_DK = 0.08838834764831845f;
constexpr float X8_SCALE = 16.f, W8_SCALE = 512.f, A8_SCALE = 8.f, O8_SCALE = 64.f, Z8_SCALE = 32.f, Y8_SCALE = 32.f;
constexpr int PC_MQ = 0, PC_MK = 512, PC_MV = 1024, PC_MO = 2048, PC_GQ = 3072, PC_GK = 3584, PC_GV = 4096, PC_GG = 5120, PC_GATEM = 6144, PC_GATEG = 8192;

constexpr size_t MiB = 1u << 20;
constexpr size_t WS_CTL = 0, CTL_ZERO_BYTES = 128 * 1024;
constexpr size_t WS_BIAS1 = 1 * MiB, WS_WRT = 1 * MiB + 65536;
#ifndef P6_FP8
#define P6_FP8 1
#endif
#ifndef P5_FP8
#define P5_FP8 1
#endif
constexpr size_t WS_WOUT8 = 60 * MiB;
constexpr size_t WS_WIN = 2 * MiB, WS_WBM = 44 * MiB, WS_WBG = 48 * MiB, WS_WOUT = 52 * MiB, WS_WGU = 64 * MiB, WS_WD = 576 * MiB;
constexpr size_t WS_XB = 832 * MiB, WS_PROJ = 960 * MiB, WS_SMALL = 1600 * MiB;
constexpr size_t WS_MSTATE = 1608 * MiB, WS_GSTATE = 1868 * MiB, WS_MPREV = 2124 * MiB, WS_GPREV = 2252 * MiB, WS_MISC = 2380 * MiB;
constexpr size_t WS_YM = 2384 * MiB, WS_YG = 2448 * MiB, WS_T1 = 2512 * MiB, WS_Z = 2768 * MiB, WS_PRE = 2896 * MiB, WS_X1 = 3152 * MiB, WS_X1B = 3408 * MiB, WS_X1F8 = 3408 * MiB;
constexpr size_t WS_XS = 960 * MiB, WS_ACT = 1504 * MiB, WS_OUTS = 2048 * MiB;
constexpr size_t WS_WIN8 = 320 * MiB;
constexpr size_t WS_XB8 = 3408 * MiB;
constexpr size_t WS_GATES = 1736 * MiB;
constexpr size_t WS_QC = WS_T1, WS_KC = WS_T1 + 32 * MiB, WS_QI = WS_T1 + 64 * MiB, WS_KI = WS_T1 + 96 * MiB;
constexpr size_t WS_SLOT = 3536 * MiB, WS_ASG = 3540 * MiB, WS_END = 3544 * MiB;
static_assert(WS_WIN + (size_t)NP1 * DM * 2 <= WS_WBM && WS_WGU + (size_t)NE * 4096 * DM * 2 <= WS_WD && WS_WD + (size_t)NE * DM * DM * 2 <= WS_XB, "ws map 1");
static_assert(WS_PROJ + (size_t)T * NPROJ * 2 <= WS_SMALL && WS_MSTATE + (size_t)NCHUNK * 257 * 128 * 4 <= WS_GSTATE && WS_GSTATE + (size_t)NCHUNK * 256 * 128 * 4 <= WS_MPREV, "ws map 2");
static_assert(WS_MSTATE + (size_t)NCHUNK * 32768 * 2 <= WS_GATES && WS_GATES + (size_t)T * 4096 <= WS_GSTATE, "gates span");
static_assert(WS_XS + (size_t)P_MAX * DM * 2 <= WS_ACT && WS_ACT + (size_t)P_MAX * DM * 2 <= WS_OUTS && WS_OUTS + (size_t)P_MAX * DM * 2 <= WS_Z, "ws map 3");
constexpr size_t MISC_NPREV = 0, MISC_MPREV = 1 * MiB, MISC_GEND = 1 * MiB + 65536, MISC_BEND = 1 * MiB + 131072, MISC_GDEC = 2 * MiB, MISC_DN = 3 * MiB;
constexpr int CW_BAR = 4096;
constexpr int CW_CNT = 16384;

constexpr int RING_BYTES = 131072;
constexpr int LDSCTL_OFF = RING_BYTES, MISC_OFF = LDSCTL_OFF + 320;
constexpr int TST_OFF = LDSCTL_OFF + 1024;
constexpr int LDS_BYTES = 147456;

__device__ __forceinline__ float bf2f(unsigned b) { return __builtin_bit_cast(float, b << 16); }
typedef _Float16 f16x2 __attribute__((ext_vector_type(2)));
typedef _Float16 f16x8 __attribute__((ext_vector_type(8)));
__device__ __forceinline__ unsigned pkh2(float lo, float hi) { const f16x2 h = {(_Float16)lo, (_Float16)hi}; return __builtin_bit_cast(unsigned, h); }
__device__ __forceinline__ float wave_sum(float v) {
#pragma unroll
    for (int o = 1; o < 64; o <<= 1) v += __shfl_xor(v, o);
    return v;
}
__device__ __forceinline__ float wave_max(float v) {
#pragma unroll
    for (int o = 1; o < 64; o <<= 1) v = fmaxf(v, __shfl_xor(v, o));
    return v;
}
__device__ __forceinline__ float logsigmoidf(float x) { return fminf(x, 0.f) - log1pf(expf(-fabsf(x))); }
__device__ __forceinline__ float sigmoid_fast(float x) { return __builtin_amdgcn_rcpf(1.f + __builtin_amdgcn_exp2f(x * -1.4426950408889634f)); }
__device__ __forceinline__ unsigned pk4_u8(float a, float b, float c, float d) {
    const unsigned ua = (unsigned)(a * 255.f + 0.5f), ub = (unsigned)(b * 255.f + 0.5f), uc = (unsigned)(c * 255.f + 0.5f), ud = (unsigned)(d * 255.f + 0.5f);
    return ua | (ub << 8) | (uc << 16) | (ud << 24); }
__device__ __forceinline__ void unpack8_u8(unsigned long long w, float (&o)[8]) {
    const unsigned lo = (unsigned)w, hi = (unsigned)(w >> 32);
    o[0] = (float)(lo & 0xffu); o[1] = (float)((lo >> 8) & 0xffu); o[2] = (float)((lo >> 16) & 0xffu); o[3] = (float)(lo >> 24);
    o[4] = (float)(hi & 0xffu); o[5] = (float)((hi >> 8) & 0xffu); o[6] = (float)((hi >> 16) & 0xffu); o[7] = (float)(hi >> 24); }
__device__ __forceinline__ float logsigmoid_fast(float x) { return fminf(x, 0.f) - __logf(1.f + __expf(-fabsf(x))); }
__device__ __forceinline__ void unpack8(const v4u r, float (&o)[8]) {
    o[0] = bf2f(r.x & 0xffffu); o[1] = bf2f(r.x >> 16); o[2] = bf2f(r.y & 0xffffu); o[3] = bf2f(r.y >> 16);
    o[4] = bf2f(r.z & 0xffffu); o[5] = bf2f(r.z >> 16); o[6] = bf2f(r.w & 0xffffu); o[7] = bf2f(r.w >> 16);
}

struct KP {
    const float *x, *w_in, *b_in, *conv_w, *conv_b, *w_gla, *b_gla, *m_norm_w, *g_norm_w, *w_bm, *w_bg, *w_out, *ln1_g, *ln1_b, *w_router, *b_router, *w_gu, *b_gu, *w_down, *b_down, *ln2_g, *ln2_b;
    float* out; unsigned char* ws;
};

#ifndef F8_GEMM1_MODE
#define F8_GEMM1_MODE 3
#endif
__host__ __device__ __forceinline__ bool f8_col_tile(int pn) { return F8_GEMM1_MODE == 0 ? false : (pn >= 24 && pn < 40) || (F8_GEMM1_MODE >= 2 && pn >= 8 && pn < 12) || (F8_GEMM1_MODE == 3 && ((pn >= 4 && pn < 8) || (pn >= 16 && pn < 20))); }
constexpr int N_F8_TILES = F8_GEMM1_MODE == 0 ? 0 : (F8_GEMM1_MODE == 3 ? 28 : (F8_GEMM1_MODE == 2 ? 20 : 16)), N_BF_TILES = 41 - N_F8_TILES;
__host__ __device__ __forceinline__ int bf_tile(int i) { return F8_GEMM1_MODE == 3 ? (i < 4 ? i : (i < 8 ? i + 8 : (i < 12 ? i + 12 : 40))) : F8_GEMM1_MODE == 2 ? (i < 8 ? i : (i < 20 ? i + 4 : 40)) : (F8_GEMM1_MODE == 1 ? (i < 24 ? i : 40) : i); }
__host__ __device__ __forceinline__ int f8_tile(int i) { return F8_GEMM1_MODE == 3 ? (i < 8 ? 4 + i : (i < 12 ? 8 + i : 12 + i)) : F8_GEMM1_MODE == 2 ? (i < 4 ? 8 + i : 20 + i) : 24 + i; }
__device__ __forceinline__ unsigned pk4_fp8(float a, float b, float c, float d) {
    a = fminf(fmaxf(a, -448.f), 448.f); b = fminf(fmaxf(b, -448.f), 448.f); c = fminf(fmaxf(c, -448.f), 448.f); d = fminf(fmaxf(d, -448.f), 448.f);
    int w = 0; w = __builtin_amdgcn_cvt_pk_fp8_f32(a, b, w, false); w = __builtin_amdgcn_cvt_pk_fp8_f32(c, d, w, true); return (unsigned)w; }
struct CvItem { const GAS float* src; unsigned char* dst; int ldw; };
__device__ __forceinline__ void cv_load(f32x4 (&v)[4][4], const CvItem& it) {
#pragma unroll
    for (int a = 0; a < 4; ++a)
#pragma unroll
        for (int b = 0; b < 4; ++b) v[a][b] = *(const GAS f32x4*)(it.src + (size_t)(4 * a + b) * it.ldw);
}
__device__ __forceinline__ void cv_finish(const f32x4 (&v)[4][4], const CvItem& it, int K, float sc, int lane) {
    const int kr = lane >> 3, ng = lane & 7;
#pragma unroll
    for (int j = 0; j < 4; ++j) { v4u o;
        o.x = pk4_fp8(v[0][0][j] * sc, v[0][1][j] * sc, v[0][2][j] * sc, v[0][3][j] * sc); o.y = pk4_fp8(v[1][0][j] * sc, v[1][1][j] * sc, v[1][2][j] * sc, v[1][3][j] * sc);
        o.z = pk4_fp8(v[2][0][j] * sc, v[2][1][j] * sc, v[2][2][j] * sc, v[2][3][j] * sc); o.w = pk4_fp8(v[3][0][j] * sc, v[3][1][j] * sc, v[3][2][j] * sc, v[3][3][j] * sc);
        *(GAS v4u*)(it.dst + (size_t)(4 * ng + j) * K + 16 * kr) = o; }
}
#ifndef SKIP_BF16_WITH_FP8
#define SKIP_BF16_WITH_FP8 1
#endif
template <class F> __device__ __forceinline__ void transpose_item16w(const float* W, int K, int ldw, bf16* WT, unsigned char* WT8, float sc8, int n0, int k0, F srccol, LAS unsigned* scr, int lane) {
    const int kr = lane >> 3, ng = lane & 7; const int scol = srccol(n0 + 4 * ng);
    const GAS float* src = (const GAS float*)(W + (size_t)(k0 + 2 * kr) * ldw + (scol >= 0 ? scol : 0));
    f32x4 v[4][2];
#pragma unroll
    for (int a = 0; a < 4; ++a)
#pragma unroll
        for (int b = 0; b < 2; ++b) { v[a][b] = *(const GAS f32x4*)(src + (size_t)(16 * a + b) * ldw); if (scol < 0) v[a][b] = (f32x4){0.f, 0.f, 0.f, 0.f}; }
#pragma unroll
    for (int a = 0; a < 4; ++a)
#pragma unroll
        for (int j = 0; j < 4; ++j) scr[(4 * ng + j) * 33 + 8 * a + kr] = pk2(v[a][0][j], v[a][1][j]);
    LAS unsigned* scr8 = scr + 32 * 33;
    if (WT8) {
#pragma unroll
        for (int a = 0; a < 4; ++a)
#pragma unroll
            for (int j = 0; j < 4; ++j) { int w = 0; w = __builtin_amdgcn_cvt_pk_fp8_f32(fminf(fmaxf(v[a][0][j] * sc8, -448.f), 448.f), fminf(fmaxf(v[a][1][j] * sc8, -448.f), 448.f), w, false);
                ((LAS unsigned short*)scr8)[(4 * ng + j) * 34 * 2 + 8 * a + kr] = (unsigned short)w; }
    }
    LDS_WAIT(); asm volatile("" ::: "memory");
    const int ch = lane & 7;
    if (!WT8 || !SKIP_BF16_WITH_FP8)
#pragma unroll
    for (int ps = 0; ps < 4; ++ps) { const int row = (lane >> 3) + 8 * ps; const LAS unsigned* s = scr + row * 33 + 4 * ch;
        v4u o; o.x = s[0]; o.y = s[1]; o.z = s[2]; o.w = s[3];
        *(GAS v4u*)(WT + (size_t)(n0 + row) * K + k0 + 8 * ch) = o; }
    if (WT8) {
#pragma unroll
        for (int ps = 0; ps < 2; ++ps) { const int row = (lane >> 2) + 16 * ps, c4 = lane & 3; const LAS unsigned* s = scr8 + row * 34 + 4 * c4;
            v4u o; o.x = s[0]; o.y = s[1]; o.z = s[2]; o.w = s[3];
            *(GAS v4u*)(WT8 + (size_t)(n0 + row) * K + k0 + 16 * c4) = o; }
    }
    LDS_WAIT(); asm volatile("" ::: "memory");
}
struct ColIdent { __device__ __forceinline__ int operator()(int n) const { return n; } };
struct ColWin { __device__ __forceinline__ int operator()(int n) const {
    if (n < 3072) return n; if (n < 6144) return n + 8; if (n < 10240) return n + 24;
    const int j = n - 10240; if (j < 8) return 3072 + j; if (j < 24) return 6152 + (j - 8); return -1; } };
struct ColGu { __device__ __forceinline__ int operator()(int n) const { const int jt = n >> 8, w = n & 255; return w < 128 ? 128 * jt + w : 2048 + 128 * jt + (w - 128); } };

__device__ __forceinline__ void p0_prologue(const KP& p, LAS unsigned char* lds, int G, int vcu, int wave, int lane) {
    LAS float* scr = (LAS float*)(lds + wave * 16384);
    const int gw = vcu * NWAVES + wave, NGW = G * NWAVES;
    unsigned char* ws = p.ws;
    bf16* WIN = (bf16*)(ws + WS_WIN); bf16* WBM = (bf16*)(ws + WS_WBM); bf16* WBG = (bf16*)(ws + WS_WBG); bf16* WOUT = (bf16*)(ws + WS_WOUT);
    constexpr int I_IN = 32 * (NP1 / 32), I_BM = 16 * 64, I_OUT = 32 * 64;
    constexpr int NITEMS = I_IN + 2 * I_BM + I_OUT;
    for (int it = gw; it < NITEMS; it += NGW) {
        int r = it;
        LAS unsigned* scu = (LAS unsigned*)scr;
        if (r < I_IN) { const int nblk = NP1 / 32; transpose_item16w(p.w_in, DM, D_IN, WIN, f8_col_tile((r % nblk) >> 3) ? ws + WS_WIN8 : (unsigned char*)nullptr, W8_SCALE, 32 * (r % nblk), 64 * (r / nblk), ColWin(), scu, lane); continue; } r -= I_IN;
        if (r < I_BM) { transpose_item16w(p.w_bm, 1024, DM, WBM, P5_FP8 ? ws + WS_WBM : (unsigned char*)nullptr, W8_SCALE, 32 * (r % 64), 64 * (r / 64), ColIdent(), scu, lane); continue; } r -= I_BM;
        if (r < I_BM) { transpose_item16w(p.w_bg, 1024, DM, WBG, P5_FP8 ? ws + WS_WBM + 2 * MiB : (unsigned char*)nullptr, W8_SCALE, 32 * (r % 64), 64 * (r / 64), ColIdent(), scu, lane); continue; } r -= I_BM;
        { transpose_item16w(p.w_out, DM, DM, WOUT, P6_FP8 ? ws + WS_WOUT8 : (unsigned char*)nullptr, W8_SCALE, 32 * (r % 64), 64 * (r / 64), ColIdent(), scu, lane); }
    }
    bf16* XB = (bf16*)(ws + WS_XB);
    for (int m = gw; m < T; m += 2 * NGW) {
        const int m2 = m + NGW; const bool has2 = m2 < T;
        f32x4 va[8], vb[8];
#pragma unroll
        for (int j = 0; j < 8; ++j) { va[j] = ((const GAS f32x4*)(p.x + (size_t)m * DM) + lane)[64 * j]; vb[j] = has2 ? ((const GAS f32x4*)(p.x + (size_t)m2 * DM) + lane)[64 * j] : (f32x4){0.f, 0.f, 0.f, 0.f}; }
#pragma unroll
        for (int r = 0; r < 2; ++r) { if (r == 1 && !has2) break; const int mm = r ? m2 : m;
            GAS unsigned long long* o8 = (GAS unsigned long long*)(XB + (size_t)mm * DM) + lane; GAS unsigned* o4 = (GAS unsigned*)(ws + WS_XB8 + (size_t)mm * DM) + lane;
#pragma unroll
            for (int j = 0; j < 8; ++j) { const f32x4 v = r ? vb[j] : va[j]; o8[64 * j] = (unsigned long long)pk2(v.x, v.y) | ((unsigned long long)pk2(v.z, v.w) << 32);
                o4[64 * j] = pk4_fp8(v.x * X8_SCALE, v.y * X8_SCALE, v.z * X8_SCALE, v.w * X8_SCALE); } }
    }
    { bf16* WRT = (bf16*)(ws + WS_WRT); for (int i = gw * 64 + lane; i < NE * DM; i += NGW * 64) WRT[i] = (bf16)(pkh2(p.w_router[(size_t)(i & (DM - 1)) * NE + (i >> 11)], 0.f) & 0xffffu); }
    float* B1 = (float*)(ws + WS_BIAS1);
    for (int n = gw * 64 + lane; n < NP1; n += NGW * 64) { const int sc = ColWin()(n); B1[n] = sc >= 0 ? p.b_in[sc] : 0.f; }
}

constexpr int CW_QHEAD = 20480;
static_assert((CW_QHEAD + 64) * 4 <= (int)CTL_ZERO_BYTES && (CW_CNT + 64 * 32) * 4 <= (int)CTL_ZERO_BYTES && (CW_BAR + 3456) * 4 <= (int)CTL_ZERO_BYTES, "control words inside the per-call memset");
__device__ __forceinline__ CvItem moe_cv_item(const KP& p, int r, int lane) {
    constexpr int I_GU = 16 * 128, I_D = 16 * 64; const int kr = lane >> 3, ng = lane & 7; CvItem it;
    if (r < NE * I_GU) { const int e = r / I_GU, q = r % I_GU, n0 = 32 * (q % 128), k0 = 128 * (q / 128);
        it.src = (const GAS float*)(p.w_gu + (size_t)e * DM * 4096 + (size_t)(k0 + 16 * kr) * 4096 + ColGu()(n0 + 4 * ng)); it.dst = p.ws + WS_WGU + (size_t)e * 4096 * DM + (size_t)n0 * DM + k0; it.ldw = 4096; }
    else { r -= NE * I_GU; const int e = r / I_D, q = r % I_D, n0 = 32 * (q % 64), k0 = 128 * (q / 64);
        it.src = (const GAS float*)(p.w_down + (size_t)e * DM * DM + (size_t)(k0 + 16 * kr) * DM + n0 + 4 * ng); it.dst = p.ws + WS_WD + (size_t)e * DM * DM + (size_t)n0 * DM + k0; it.ldw = DM; }
    return it;
}
constexpr int NQ_GU = NE * 16 * 128, NQ_ALL = NE * (16 * 128 + 16 * 64);
__device__ __forceinline__ void moe_convert_queue(const KP& p, LAS unsigned char* lds, gu32* ctl, int wave, int lane, int qw, int r_lo, int r_hi) {
    (void)lds; (void)wave;
    constexpr int QCHUNK = 8;
    static_assert(NQ_GU % 64 == 0 && NQ_ALL % 64 == 0 && QCHUNK == 8, "queue chunking");
    for (;;) {
        unsigned base = 0; if (lane == 0) base = __hip_atomic_fetch_add(ctl + qw, (unsigned)QCHUNK, RLX_AGENT);
        base = (unsigned)__builtin_amdgcn_readfirstlane((int)base) + (unsigned)r_lo;
        if (base >= (unsigned)r_hi) break;
#ifdef CONV_INTERLEAVE
        { const unsigned c = (base - (unsigned)r_lo) / QCHUNK; base = (unsigned)r_lo + (c >> 3) * 64u + (c & 7u); }
        constexpr int QS = 8;
#else
        constexpr int QS = 1;
#endif
        f32x4 va[4][4], vb[4][4]; CvItem ia = moe_cv_item(p, (int)base, lane), ib = ia;
        cv_load(va, ia);
#pragma unroll
        for (int j = 0; j < QCHUNK; j += 2) {
            ib = moe_cv_item(p, (int)base + QS * (j + 1), lane); cv_load(vb, ib);
            cv_finish(va, ia, DM, W8_SCALE, lane);
            if (j + 2 < QCHUNK) { ia = moe_cv_item(p, (int)base + QS * (j + 2), lane); cv_load(va, ia); }
            cv_finish(vb, ib, DM, W8_SCALE, lane);
        }
    }
}

__device__ __forceinline__ size_t gate_off(int g, int pm, int pz, int q, int wr, int wc, int fr, int fq) {
    return ((((size_t)(g * 128 + pm) * 8 + pz) * 8 + (q >> 1)) * 8 + (wr * 4 + wc)) * 1024 + (size_t)(fq * 16 + fr) * 16 + (size_t)(q & 1) * 8; }
struct EpiProj {
    static constexpr bool PERM = true, AFTER_DRAIN = false, CHAIN = false, HAS_PRE = false;
    bf16* PROJ; float* SMALL; const float* bias; float inv;
    __device__ __forceinline__ void operator()(const pg8::f32x4 (&acc)[2][2][4][2], const pg8::Unit& u, int wr, int wc, int fr, int fq) const {
        const int row0 = u.pm * 256 + wr * 64 + fr;
        if (u.pn == 40) {
            if (wc == 0) {
                const float* bp = bias + 10240 + 8 * fq;
                const f32x4 b0 = *(const f32x4*)bp, b1 = *(const f32x4*)(bp + 4);
#pragma unroll
                for (int ai = 0; ai < 2; ++ai)
#pragma unroll
                    for (int m = 0; m < 4; ++m) { float* rp = SMALL + (size_t)(row0 + ai * 128 + m * 16) * 32 + 8 * fq;
                        *(f32x4*)rp = acc[ai][0][m][0] * inv + b0; *(f32x4*)(rp + 4) = acc[ai][0][m][1] * inv + b1; }
            }
            return;
        }
        const int pn = u.pn;
        const int act = (pn >= 8 && pn < 12) || pn >= 24 ? 1 : ((pn >= 20 && pn < 24) ? 2 : 0);
        const int col0 = pn * 256 + wc * 32 + 8 * fq;
        f32x4 bv[2][2];
#pragma unroll
        for (int bj = 0; bj < 2; ++bj)
#pragma unroll
            for (int n = 0; n < 2; ++n) bv[bj][n] = *(const f32x4*)(bias + col0 + bj * 128 + 4 * n);
#pragma unroll
        for (int ai = 0; ai < 2; ++ai)
#pragma unroll
            for (int m = 0; m < 4; ++m) { bf16* rowp = PROJ + (size_t)(row0 + ai * 128 + m * 16) * NPROJ + col0;
#pragma unroll
                for (int bj = 0; bj < 2; ++bj) { const f32x4 p0 = acc[ai][bj][m][0] * inv + bv[bj][0], p1 = acc[ai][bj][m][1] * inv + bv[bj][1];
                    float r[8] = {p0.x, p0.y, p0.z, p0.w, p1.x, p1.y, p1.z, p1.w};
                    if (act) {
#pragma unroll
                        for (int j = 0; j < 8; ++j) { const float sg = sigmoid_fast(r[j]); r[j] = act == 1 ? sg : r[j] * sg; }
                    }
                    if (pn >= 24) {
                        const unsigned long long w8 = (unsigned long long)pk4_u8(r[0], r[1], r[2], r[3]) | ((unsigned long long)pk4_u8(r[4], r[5], r[6], r[7]) << 32);
                        *(unsigned long long*)((unsigned char*)PROJ + (WS_GATES - WS_PROJ) + gate_off((pn - 24) >> 3, u.pm, (pn - 24) & 7, (ai * 4 + m) * 2 + bj, wr, wc, fr, fq)) = w8;
                    } else {
                        pg8::u32x4 w; w.x = pg8::cvt_pk_bf16(r[0], r[1]); w.y = pg8::cvt_pk_bf16(r[2], r[3]); w.z = pg8::cvt_pk_bf16(r[4], r[5]); w.w = pg8::cvt_pk_bf16(r[6], r[7]);
                        *(pg8::u32x4*)(rowp + bj * 128) = w; } } }
    }
};
struct EpiBranchFused {
    static constexpr bool PERM = true, AFTER_DRAIN = false, CHAIN = true, HAS_PRE = false;
    bf16* Z; const unsigned char* GATES;
    __device__ __forceinline__ bool chain(pg8::f32x4 (&acc)[2][2][4][2], const pg8::Unit& u, int wr, int wc, int fr, int fq) const {
        const bool second = u.pm >= 128; const int pm = second ? u.pm - 128 : u.pm, pn = second ? u.pn - 8 : u.pn;
        const int row0 = pm * 256 + wr * 64 + fr, col0 = pn * 256 + wc * 32 + 8 * fq;
        if (!second) {
            unsigned long long gga[2][4][2], gma[2][4][2];
#pragma unroll
            for (int ai = 0; ai < 2; ++ai)
#pragma unroll
                for (int m = 0; m < 4; ++m)
#pragma unroll
                    for (int bj = 0; bj < 2; ++bj) { const int q = (ai * 4 + m) * 2 + bj;
                        gma[ai][m][bj] = *(const GAS unsigned long long*)(GATES + gate_off(0, pm, pn, q, wr, wc, fr, fq)); gga[ai][m][bj] = *(const GAS unsigned long long*)(GATES + gate_off(1, pm, pn, q, wr, wc, fr, fq)); }
#pragma unroll
            for (int ai = 0; ai < 2; ++ai)
#pragma unroll
                for (int m = 0; m < 4; ++m)
#pragma unroll
                    for (int bj = 0; bj < 2; ++bj) { float gg[8], gm[8]; unpack8_u8(gga[ai][m][bj], gg); unpack8_u8(gma[ai][m][bj], gm);
#pragma unroll
                        for (int j = 0; j < 4; ++j) { acc[ai][bj][m][0][j] *= gm[j] * __builtin_amdgcn_rcpf(fmaxf(gg[j], 0.5f)); acc[ai][bj][m][1][j] *= gm[4 + j] * __builtin_amdgcn_rcpf(fmaxf(gg[4 + j], 0.5f)); } }
            return true;
        }
        unsigned long long gga[2][4][2];
#pragma unroll
        for (int ai = 0; ai < 2; ++ai)
#pragma unroll
            for (int m = 0; m < 4; ++m)
#pragma unroll
                for (int bj = 0; bj < 2; ++bj) gga[ai][m][bj] = *(const GAS unsigned long long*)(GATES + gate_off(1, pm, pn, (ai * 4 + m) * 2 + bj, wr, wc, fr, fq));
#pragma unroll
        for (int ai = 0; ai < 2; ++ai)
#pragma unroll
            for (int m = 0; m < 4; ++m)
#pragma unroll
                for (int bj = 0; bj < 2; ++bj) { float gg[8]; unpack8_u8(gga[ai][m][bj], gg);
#pragma unroll
                    for (int j = 0; j < 8; ++j) gg[j] = fmaxf(gg[j], 0.5f) * (P5_FP8 ? 1.f / (255.f * Y8_SCALE * W8_SCALE) : 1.f / 255.f);
                    const pg8::f32x4 a0 = acc[ai][bj][m][0], a1 = acc[ai][bj][m][1];
                    if constexpr (P6_FP8) {
#pragma unroll
                        for (int j = 0; j < 8; ++j) gg[j] *= Z8_SCALE;
                        *(unsigned long long*)((unsigned char*)Z + (size_t)(row0 + ai * 128 + m * 16) * DM + col0 + bj * 128) =
                            (unsigned long long)pk4_fp8(gg[0] * a0[0], gg[1] * a0[1], gg[2] * a0[2], gg[3] * a0[3]) | ((unsigned long long)pk4_fp8(gg[4] * a1[0], gg[5] * a1[1], gg[6] * a1[2], gg[7] * a1[3]) << 32);
                    } else {
                    pg8::u32x4 w; w.x = pg8::cvt_pk_bf16(gg[0] * a0[0], gg[1] * a0[1]); w.y = pg8::cvt_pk_bf16(gg[2] * a0[2], gg[3] * a0[3]);
                    w.z = pg8::cvt_pk_bf16(gg[4] * a1[0], gg[5] * a1[1]); w.w = pg8::cvt_pk_bf16(gg[6] * a1[2], gg[7] * a1[3]);
                    *(pg8::u32x4*)(Z + (size_t)(row0 + ai * 128 + m * 16) * DM + col0 + bj * 128) = w; } }
        return false;
    }
};
struct PairOrder : pg8::StaticOrder {
    __device__ __forceinline__ bool next(int i, pg8::Unit& u) const { if (!pg8::StaticOrder::next(i >> 1, u)) return false; if (i & 1) { u.pm += 128; u.pn += 8; } return true; }
    __device__ __forceinline__ unsigned a_row(const pg8::Unit& u, int r) const { return (unsigned)(u.pm * 256 + r); } };
struct EpiMix {
    static constexpr bool PERM = true, AFTER_DRAIN = false, CHAIN = false, HAS_PRE = false;
    bf16* MIX; float inv;
    __device__ __forceinline__ void operator()(const pg8::f32x4 (&acc)[2][2][4][2], const pg8::Unit& u, int wr, int wc, int fr, int fq) const {
        const int row0 = u.pm * 256 + wr * 64 + fr, col0 = u.pn * 256 + wc * 32 + 8 * fq;
#pragma unroll
        for (int ai = 0; ai < 2; ++ai)
#pragma unroll
            for (int m = 0; m < 4; ++m) { bf16* rowp = MIX + (size_t)(row0 + ai * 128 + m * 16) * DM + col0;
#pragma unroll
                for (int bj = 0; bj < 2; ++bj) { const pg8::f32x4 v0 = acc[ai][bj][m][0] * inv, v1 = acc[ai][bj][m][1] * inv;
                    pg8::u32x4 w; w.x = pg8::cvt_pk_bf16(v0[0], v0[1]); w.y = pg8::cvt_pk_bf16(v0[2], v0[3]); w.z = pg8::cvt_pk_bf16(v1[0], v1[1]); w.w = pg8::cvt_pk_bf16(v1[2], v1[3]);
                    *(pg8::u32x4*)(rowp + bj * 128) = w; } }
    }
};
struct EpiSwiglu {
    static constexpr bool PERM = true, AFTER_DRAIN = false, CHAIN = false, HAS_PRE = true;
    unsigned char* ACT; const float* b_gu;
    __device__ __forceinline__ void prefetch(LAS float* pad, const pg8::Unit& u, int wc, int lane) const {
        const int e = u.pn >> 4, jt = u.pn & 15; const float* src = b_gu + (size_t)e * 4096 + 128 * jt + wc * 32 + (lane & 31) + (lane >> 5) * 2048;
        __builtin_amdgcn_global_load_lds((const unsigned*)src, (LAS unsigned*)pad, 4, 0, 0); }
    __device__ __forceinline__ void operator()(const pg8::f32x4 (&acc)[2][2][4][2], const pg8::Unit& u, int wr, int wc, int fr, int fq, const LAS float* pad) const {
        const int e = u.pn >> 4, jt = u.pn & 15;
        const int row0 = u.pm * 256 + wr * 64 + fr, c0 = 128 * jt + wc * 32 + 8 * fq;
        const float* bg = b_gu + (size_t)e * 4096 + c0; constexpr float inv = 1.f / (X8_SCALE * W8_SCALE);
        const f32x4 bg0 = *(const LAS f32x4*)(pad + 8 * fq), bg1 = *(const LAS f32x4*)(pad + 8 * fq + 4), bl0 = *(const LAS f32x4*)(pad + 32 + 8 * fq), bl1 = *(const LAS f32x4*)(pad + 36 + 8 * fq); (void)bg;
#pragma unroll
        for (int ai = 0; ai < 2; ++ai)
#pragma unroll
            for (int m = 0; m < 4; ++m) { const size_t row = (size_t)(row0 + ai * 128 + m * 16);
                const f32x4 g0 = acc[ai][0][m][0] * inv + bg0, g1 = acc[ai][0][m][1] * inv + bg1, l0 = acc[ai][1][m][0] * inv + bl0, l1 = acc[ai][1][m][1] * inv + bl1;
                float r[8];
#pragma unroll
                for (int j = 0; j < 4; ++j) {
                    const float a = fminf(g0[j], 7.f), b = fminf(fmaxf(l0[j], -7.f), 7.f); r[j] = a * sigmoid_fast(1.702f * a) * (b + 1.f) * A8_SCALE;
                    const float a2 = fminf(g1[j], 7.f), b2 = fminf(fmaxf(l1[j], -7.f), 7.f); r[4 + j] = a2 * sigmoid_fast(1.702f * a2) * (b2 + 1.f) * A8_SCALE; }
                const unsigned long long w = (unsigned long long)pk4_fp8(r[0], r[1], r[2], r[3]) | ((unsigned long long)pk4_fp8(r[4], r[5], r[6], r[7]) << 32);
                *(unsigned long long*)(ACT + row * DFF + c0) = w; }
    }
};
struct EpiDown {
    static constexpr bool PERM = true, AFTER_DRAIN = false, CHAIN = false, HAS_PRE = true;
    unsigned char* OUTS; const float* b_down;
    __device__ __forceinline__ void prefetch(LAS float* pad, const pg8::Unit& u, int wc, int lane) const {
        const int e = u.pn >> 3, jt = u.pn & 7; const float* src = b_down + (size_t)e * DM + 256 * jt + wc * 32 + (lane & 31) + (lane >> 5) * 128;
        __builtin_amdgcn_global_load_lds((const unsigned*)src, (LAS unsigned*)pad, 4, 0, 0); }
    __device__ __forceinline__ void operator()(const pg8::f32x4 (&acc)[2][2][4][2], const pg8::Unit& u, int wr, int wc, int fr, int fq, const LAS float* pad) const {
        const int e = u.pn >> 3, jt = u.pn & 7;
        const int row0 = u.pm * 256 + wr * 64 + fr, c0 = 256 * jt + wc * 32 + 8 * fq;
        const float* bd = b_down + (size_t)e * DM + c0; constexpr float inv = O8_SCALE / (A8_SCALE * W8_SCALE);
        f32x4 bv[2][2];
#pragma unroll
        for (int bj = 0; bj < 2; ++bj)
#pragma unroll
            for (int n = 0; n < 2; ++n) bv[bj][n] = *(const LAS f32x4*)(pad + 32 * bj + 8 * fq + 4 * n) * O8_SCALE;
#pragma unroll
        for (int ai = 0; ai < 2; ++ai)
#pragma unroll
            for (int m = 0; m < 4; ++m) { unsigned char* rowp = OUTS + (size_t)(row0 + ai * 128 + m * 16) * DM + c0;
#pragma unroll
                for (int bj = 0; bj < 2; ++bj) { const f32x4 v0 = acc[ai][bj][m][0] * inv + bv[bj][0], v1 = acc[ai][bj][m][1] * inv + bv[bj][1];
                    *(unsigned long long*)(rowp + bj * 128) = (unsigned long long)pk4_fp8(v0[0], v0[1], v0[2], v0[3]) | ((unsigned long long)pk4_fp8(v1[0], v1[1], v1[2], v1[3]) << 32); } }
    }
};
struct SubsetOrderBf : pg8::StaticOrder { __device__ __forceinline__ bool next(int i, pg8::Unit& u) const { if (!pg8::StaticOrder::next(i, u)) return false; u.pn = bf_tile(u.pn); return true; } };
struct SubsetOrderF8 : pg8::StaticOrder { __device__ __forceinline__ bool next(int i, pg8::Unit& u) const { if (!pg8::StaticOrder::next(i, u)) return false; u.pn = f8_tile(u.pn); return true; }
    __device__ __forceinline__ unsigned a_row(const pg8::Unit& u, int r) const { return (unsigned)(u.pm * 256 + r); } };
struct StaticOrder8 : pg8::StaticOrder { __device__ __forceinline__ unsigned a_row(const pg8::Unit& u, int r) const { return (unsigned)(u.pm * 256 + r); } };
struct MoeOrder {
    const LAS int* tst; int G, c, nN;
    __device__ __forceinline__ bool next(int i, pg8::Unit& u) const {
        int rt, nt;
        if (G == 256) {
            const int x = c & 7, j = c >> 3;
            if (nN == 16) { rt = 16 * i + 4 * (x >> 1) + (j >> 3); nt = 8 * (x & 1) + (j & 7); } else { rt = 32 * i + 4 * x + (j >> 3); nt = j & 7; }
            if (rt >= tst[32]) return false;
        } else { const int L = i * G + c; const int total = tst[32] * nN; if (L >= total) return false; rt = L / nN; nt = L % nN; }
        int e = 0;
#pragma unroll 1
        for (int k = 1; k < 32; ++k) e += (tst[k] <= rt) ? 1 : 0;
        u.pm = rt; u.pn = e * nN + nt; return true;
    }
    __device__ __forceinline__ void a_ready(const pg8::Unit&) const {}
    __device__ __forceinline__ void done(const pg8::Unit&) const {}
    const int* slot;
    __device__ __forceinline__ unsigned a_row(const pg8::Unit& u, int r) const {
        if (!slot) return (unsigned)(u.pm * 256 + r);
        const int e = u.pn / nN; int idx = (u.pm - tst[e]) * 256 + r; const int cnt = tst[33 + e]; idx = idx < cnt ? idx : cnt - 1;
        return (unsigned)slot[(size_t)e * T + idx]; }
};
__device__ __forceinline__ void moe_tables(const gu32* ctl, LAS int* tst, int tid) {
    if (tid < 32) tst[33 + tid] = (int)__hip_atomic_load(ctl + CW_CNT + 64 * tid, RLX_AGENT);
    __syncthreads();
    if (tid == 0) { int a = 0; for (int e = 0; e < 32; ++e) { tst[e] = a; a += (tst[33 + e] + 255) >> 8; } tst[32] = a; }
    __syncthreads();
}

struct ConvW { float w[4][8]; float b[8]; };
__device__ __forceinline__ void load_convw(ConvW& cw, const float* conv_w, const float* conv_b, int ch) {
#pragma unroll
    for (int j = 0; j < 4; ++j) { const f32x4 a = *(const f32x4*)(conv_w + j * 1024 + ch), b = *(const f32x4*)(conv_w + j * 1024 + ch + 4);
        cw.w[j][0] = a.x; cw.w[j][1] = a.y; cw.w[j][2] = a.z; cw.w[j][3] = a.w; cw.w[j][4] = b.x; cw.w[j][5] = b.y; cw.w[j][6] = b.z; cw.w[j][7] = b.w; }
    const f32x4 a = *(const f32x4*)(conv_b + ch), b = *(const f32x4*)(conv_b + ch + 4);
    cw.b[0] = a.x; cw.b[1] = a.y; cw.b[2] = a.z; cw.b[3] = a.w; cw.b[4] = b.x; cw.b[5] = b.y; cw.b[6] = b.z; cw.b[7] = b.w;
}
__device__ __forceinline__ void conv_silu8(const bf16* src, size_t trow, int pos, const ConvW& cw, float (&o)[8]) {
#pragma unroll
    for (int d = 0; d < 8; ++d) o[d] = cw.b[d];
#pragma unroll
    for (int j = 0; j < 4; ++j) { if (pos - 3 + j >= 0) { const v4u r = *(const GAS v4u*)(src + (trow - 3 + j) * NPROJ); float f[8]; unpack8(r, f);
#pragma unroll
            for (int d = 0; d < 8; ++d) o[d] += cw.w[j][d] * f[d]; } }
#pragma unroll
    for (int d = 0; d < 8; ++d) o[d] = o[d] * sigmoid_fast(o[d]);
}
__device__ __forceinline__ void gla_cum(const KP& p, const float* SMALL, size_t t0, int h, LAS float* cumL, LAS float* tot, LAS float* glr_s, int tid) {
    for (int i = tid; i < 64 * 16; i += NTHR) glr_s[i] = SMALL[(t0 + (i >> 4)) * 32 + 8 + (i & 15)];
    const int dk = tid & 127, sq = tid >> 7;
    float wg[16];
#pragma unroll
    for (int r = 0; r < 16; ++r) wg[r] = p.w_gla[r * 512 + h * 128 + dk];
    const float bgv = p.b_gla[h * 128 + dk];
    __syncthreads();
    float run = 0.f; float loc[16];
#pragma unroll
    for (int i = 0; i < 16; ++i) { const int s = 16 * sq + i; float z = bgv;
#pragma unroll
        for (int r = 0; r < 16; ++r) z += glr_s[s * 16 + r] * wg[r];
        run += logsigmoid_fast(z) * (1.f / 16.f); loc[i] = run; }
    tot[sq * 128 + dk] = run;
    __syncthreads();
    float off = 0.f;
#pragma unroll
    for (int j = 0; j < 3; ++j) off += (j < sq) ? tot[j * 128 + dk] : 0.f;
#pragma unroll
    for (int i = 0; i < 16; ++i) cumL[(16 * sq + i) * 128 + dk] = loc[i] + off;
    __syncthreads();
}
constexpr int VN_PITCH = 544;
typedef short v4i16_t __attribute__((ext_vector_type(4)));
template <int PITCH> __device__ __forceinline__ bf16x8 frag_tr(const LAS unsigned char* tile, int ct, int ks, int fr, int fq) {
    const LAS unsigned char* a = tile + (32 * ks + 8 * fq + (fr >> 2)) * PITCH + (16 * ct + 4 * (fr & 3)) * 2;
    const v4i16_t lo = __builtin_amdgcn_ds_read_tr16_b64_v4i16((LAS v4i16_t*)a), hi = __builtin_amdgcn_ds_read_tr16_b64_v4i16((LAS v4i16_t*)(a + 4 * PITCH));
    return __builtin_shufflevector(lo, hi, 0, 1, 2, 3, 4, 5, 6, 7);
}
__device__ __forceinline__ bf16x8 vfrag_tr(const LAS unsigned char* vN, int dvt, int ks, int fr, int fq) {
    const LAS unsigned char* a = vN + (32 * ks + 8 * fq + (fr >> 2)) * VN_PITCH + (((16 * dvt + 4 * (fr & 3)) * 2) ^ ((fq & 1) << 7));
    const v4i16_t lo = __builtin_amdgcn_ds_read_tr16_b64_v4i16((LAS v4i16_t*)a), hi = __builtin_amdgcn_ds_read_tr16_b64_v4i16((LAS v4i16_t*)(a + 4 * VN_PITCH));
    return __builtin_shufflevector(lo, hi, 0, 1, 2, 3, 4, 5, 6, 7); }
constexpr int KN_PITCH = 288;
__device__ __forceinline__ int kn_off(int row, int byte) { return row * KN_PITCH + (byte ^ (((row >> 3) & 1) << 7)); }
__device__ __forceinline__ void vN_store(LAS unsigned char* vN, int idx, v4u r) { *(LAS v4u*)(vN + (idx >> 5) * VN_PITCH + (((idx & 31) ^ (((idx >> 8) & 1) << 3)) * 16)) = r; }
__device__ __forceinline__ void state_mfma_store(const LAS unsigned char* vN, const LAS unsigned char* keN, bf16* dst, int wave, int lane) {
    const int fr = lane & 15, fq = lane >> 4;
    bf16x8 bvv[2][2];
#pragma unroll
    for (int i = 0; i < 2; ++i)
#pragma unroll
        for (int ks = 0; ks < 2; ++ks) bvv[i][ks] = vfrag_tr(vN, 2 * wave + i, ks, fr, fq);
#pragma unroll
    for (int j = 0; j < 8; ++j) { bf16x8 a[2];
#pragma unroll
        for (int ks = 0; ks < 2; ++ks) { const LAS unsigned char* ap = keN + (32 * ks + 8 * fq + (fr >> 2)) * KN_PITCH + (((16 * j + 4 * (fr & 3)) * 2) ^ ((fq & 1) << 7));
            const v4i16_t lo = __builtin_amdgcn_ds_read_tr16_b64_v4i16((LAS v4i16_t*)ap), hi = __builtin_amdgcn_ds_read_tr16_b64_v4i16((LAS v4i16_t*)(ap + 4 * KN_PITCH));
            a[ks] = __builtin_shufflevector(lo, hi, 0, 1, 2, 3, 4, 5, 6, 7); }
#pragma unroll
        for (int i = 0; i < 2; ++i) { f32x4 acc = {0.f, 0.f, 0.f, 0.f};
#pragma unroll
            for (int ks = 0; ks < 2; ++ks) acc = __builtin_amdgcn_mfma_f32_16x16x32_bf16(a[ks], bvv[i][ks], acc, 0, 0, 0);
            *(GAS unsigned long long*)(dst + ((size_t)((2 * wave + i) * 16 + 2 * j + (fq >> 1)) * 16 + fr) * 8 + 4 * (fq & 1)) = (unsigned long long)pk2(acc[0], acc[1]) | ((unsigned long long)pk2(acc[2], acc[3]) << 32); } }
}

struct LocPreM { v4u rv[4], rq[5], rk[5]; float fp, ip; };
struct LocOffM { unsigned vo; int ro; };
__device__ __forceinline__ void locm_prefetch(LocPreM& P, const LocOffM& O, const KP& p, int cid, int lane, int wave, int sp) {
    unsigned char* ws = p.ws;
    const int bh = cid >> 6, c = cid & 63, b = bh >> 2, h = bh & 3; const size_t t0 = (size_t)b * SEQ + c * 64;
    const char* vb = (const char*)((const bf16*)(ws + WS_PROJ) + t0 * NPROJ + PC_MV + h * 256);
    const char* qb = (const char*)((const bf16*)(ws + WS_PROJ) + t0 * NPROJ + PC_MQ + h * 128);
    const char* kb = (const char*)((const bf16*)(ws + WS_PROJ) + t0 * NPROJ + PC_MK + h * 128);
#pragma unroll
    for (int i = 0; i < 4; ++i) P.rv[i] = *(const GAS v4u*)(vb + (size_t)i * 16 * NPROJ * 2 + O.vo);
#pragma unroll
    for (int j = 0; j < 5; ++j) { const bool ok = (c > 0) || (2 * sp - 3 + j >= 0);
        const long off = (long)O.ro + (long)j * NPROJ * 2;
        P.rq[j] = ok ? *(const GAS v4u*)(qb + off) : (v4u){0u, 0u, 0u, 0u}; P.rk[j] = ok ? *(const GAS v4u*)(kb + off) : (v4u){0u, 0u, 0u, 0u}; }
    P.fp = 0.f; P.ip = 0.f;
    if (wave == 0) { const float* SMALL = (const float*)(ws + WS_SMALL); P.fp = SMALL[(t0 + lane) * 32 + 4 + h]; P.ip = SMALL[(t0 + lane) * 32 + h]; }
}
__device__ __forceinline__ void conv2_silu8(const v4u (&r)[5], const ConvW& cw, float (&o0)[8], float (&o1)[8]) {
    float f[5][8];
#pragma unroll
    for (int j = 0; j < 5; ++j) unpack8(r[j], f[j]);
#pragma unroll
    for (int d = 0; d < 8; ++d) { float a = cw.b[d], bb = cw.b[d];
#pragma unroll
        for (int j = 0; j < 4; ++j) { a += cw.w[j][d] * f[j][d]; bb += cw.w[j][d] * f[j + 1][d]; }
        o0[d] = a * sigmoid_fast(a); o1[d] = bb * sigmoid_fast(bb); }
}
template <int LOCX = 0> __device__ __forceinline__ void mixer_local_mlstm(const KP& p, LAS unsigned char* L, int bx, int G, int tid, int lane, int wave) {
    unsigned char* ws = p.ws;
    LAS unsigned char* vN = L + 0; LAS unsigned char* keN = L + 36864; LAS float* wexp = (LAS float*)(L + 55296);
    const int d8 = tid & 15, sp = tid >> 4;
    if (bx >= NCHUNK) return;
    LocOffM O; O.vo = (unsigned)(((tid >> 5) * NPROJ + (tid & 31) * 8) * 2); O.ro = ((2 * sp - 3) * NPROJ + d8 * 8) * 2;
    LocPreM P; locm_prefetch(P, O, p, bx, lane, wave, sp);
#pragma unroll 1
    for (int cid = bx; cid < NCHUNK; cid += G) {
        const int bh = cid >> 6, c = cid & 63, b = bh >> 2, h = bh & 3; const size_t t0 = (size_t)b * SEQ + c * 64;
        if (wave == 0) {
            float bc = logsigmoidf(P.fp); const float ip = P.ip;
#pragma unroll
            for (int o = 1; o < 64; o <<= 1) { const float n = __shfl_up(bc, o); if (lane >= o) bc += n; }
            const float bend = __shfl(bc, 63);
            const float w = bend - bc + ip; const float g = wave_max(w);
            wexp[lane] = expf(w - g);
            if (lane == 0) { ((float*)(ws + WS_MISC + MISC_GEND))[cid] = g; ((float*)(ws + WS_MISC + MISC_BEND))[cid] = bend; }
        }
#pragma unroll
        for (int i = 0; i < ((LOCX & 8) ? 1 : 4); ++i) vN_store(vN, tid + NTHR * i, P.rv[i]);
        float k0[8], k1[8];
        { ConvW cwq; load_convw(cwq, p.conv_w, p.conv_b, h * 128 + d8 * 8); float q0[8], q1[8]; if (!(LOCX & 4)) conv2_silu8(P.rq, cwq, q0, q1); else { for (int d = 0; d < 8; ++d) { q0[d] = bf2f(P.rq[0].x) + d; q1[d] = bf2f(P.rq[4].y) + d; } } bf16* QC = (bf16*)(ws + WS_QC) + (t0 + 2 * sp) * 512 + h * 128 + d8 * 8;
          v4u w; w.x = pk2(q0[0], q0[1]); w.y = pk2(q0[2], q0[3]); w.z = pk2(q0[4], q0[5]); w.w = pk2(q0[6], q0[7]); *(GAS v4u*)QC = w;
          w.x = pk2(q1[0], q1[1]); w.y = pk2(q1[2], q1[3]); w.z = pk2(q1[4], q1[5]); w.w = pk2(q1[6], q1[7]); *(GAS v4u*)(QC + 512) = w; }
        { ConvW cwk; load_convw(cwk, p.conv_w, p.conv_b, 512 + h * 128 + d8 * 8); if (!(LOCX & 4)) conv2_silu8(P.rk, cwk, k0, k1); else { for (int d = 0; d < 8; ++d) { k0[d] = bf2f(P.rk[0].x) + d; k1[d] = bf2f(P.rk[4].y) + d; } } bf16* KC = (bf16*)(ws + WS_KC) + (t0 + 2 * sp) * 512 + h * 128 + d8 * 8;
#pragma unroll
          for (int d = 0; d < 8; ++d) { k0[d] *= RSQRT_DK; k1[d] *= RSQRT_DK; }
          v4u w; w.x = pk2(k0[0], k0[1]); w.y = pk2(k0[2], k0[3]); w.z = pk2(k0[4], k0[5]); w.w = pk2(k0[6], k0[7]); *(GAS v4u*)KC = w;
          w.x = pk2(k1[0], k1[1]); w.y = pk2(k1[2], k1[3]); w.z = pk2(k1[4], k1[5]); w.w = pk2(k1[6], k1[7]); *(GAS v4u*)(KC + 512) = w; }
        __syncthreads();
        if (cid + G < NCHUNK) locm_prefetch(P, O, p, cid + G, lane, wave, sp);
        __builtin_amdgcn_sched_barrier(0);
        { const float w0 = wexp[2 * sp], w1 = wexp[2 * sp + 1]; v4u w;
          w.x = pk2(k0[0] * w0, k0[1] * w0); w.y = pk2(k0[2] * w0, k0[3] * w0); w.z = pk2(k0[4] * w0, k0[5] * w0); w.w = pk2(k0[6] * w0, k0[7] * w0); *(LAS v4u*)(keN + kn_off(2 * sp, d8 * 16)) = w;
          w.x = pk2(k1[0] * w1, k1[1] * w1); w.y = pk2(k1[2] * w1, k1[3] * w1); w.z = pk2(k1[4] * w1, k1[5] * w1); w.w = pk2(k1[6] * w1, k1[7] * w1); *(LAS v4u*)(keN + kn_off(2 * sp + 1, d8 * 16)) = w; }
        __syncthreads();
        if (!(LOCX & 2)) { const int dk = tid >> 2, qq = tid & 3; float sum = 0.f;
#pragma unroll
            for (int s = 0; s < 16; ++s) sum += bf2f(*(const LAS bf16*)(keN + kn_off(16 * qq + s, dk * 2)));
            sum += __shfl_xor(sum, 1); sum += __shfl_xor(sum, 2);
            if (qq == 0) ((float*)(ws + WS_MISC + MISC_DN))[(size_t)cid * 128 + dk] = sum; }
        if (!(LOCX & 1)) state_mfma_store(vN, keN, (bf16*)(ws + WS_MSTATE) + (size_t)cid * 32768, wave, lane);
        __syncthreads();
    }
}
struct LocPreG { v4u rv[4], rq[2], rk[2]; float g0, g1; };
__device__ __forceinline__ void locg_prefetch(LocPreG& P, unsigned vo, unsigned qo, const KP& p, int cid, int tid) {
    unsigned char* ws = p.ws;
    const int bh = cid >> 6, c = cid & 63, b = bh >> 2, h = bh & 3; const size_t t0 = (size_t)b * SEQ + c * 64;
    const char* vb = (const char*)((const bf16*)(ws + WS_PROJ) + t0 * NPROJ + PC_GV + h * 256);
    const char* qb = (const char*)((const bf16*)(ws + WS_PROJ) + t0 * NPROJ + PC_GQ + h * 128);
    const char* kb = (const char*)((const bf16*)(ws + WS_PROJ) + t0 * NPROJ + PC_GK + h * 128);
#pragma unroll
    for (int i = 0; i < 4; ++i) P.rv[i] = *(const GAS v4u*)(vb + (size_t)i * 16 * NPROJ * 2 + vo);
#pragma unroll
    for (int i = 0; i < 2; ++i) { P.rq[i] = *(const GAS v4u*)(qb + (size_t)i * 32 * NPROJ * 2 + qo); P.rk[i] = *(const GAS v4u*)(kb + (size_t)i * 32 * NPROJ * 2 + qo); }
    const float* SMALL = (const float*)(ws + WS_SMALL);
    P.g0 = SMALL[(t0 + (tid >> 4)) * 32 + 8 + (tid & 15)]; P.g1 = SMALL[(t0 + 32 + (tid >> 4)) * 32 + 8 + (tid & 15)];
}
__device__ __forceinline__ void mixer_local_gla(const KP& p, LAS unsigned char* L, int bx, int G, int tid, int lane, int wave) {
    unsigned char* ws = p.ws;
    LAS unsigned char* vN = L + 0; LAS unsigned char* keN = L + 36864;
    LAS float* cumL = (LAS float*)(L + 57344); LAS float* tot = (LAS float*)(L + 57344 + 32768); LAS float* glr_s = (LAS float*)(L + 57344 + 32768 + 2048);
    const int d8 = tid & 15;
    if (bx >= NCHUNK) return;
    const unsigned vo = (unsigned)(((tid >> 5) * NPROJ + (tid & 31) * 8) * 2), qo = (unsigned)(((tid >> 4) * NPROJ + d8 * 8) * 2);
    LocPreG P; locg_prefetch(P, vo, qo, p, bx, tid);
    int hw = -1; float wg[16]; float bgv = 0.f;
#pragma unroll
    for (int r = 0; r < 16; ++r) wg[r] = 0.f;
#pragma unroll 1
    for (int cid = bx; cid < NCHUNK; cid += G) {
        const int bh = cid >> 6, c = cid & 63, b = bh >> 2, h = bh & 3; const size_t t0 = (size_t)b * SEQ + c * 64;
        const int dk = tid & 127, sq = tid >> 7;
        if (h != hw) {
#pragma unroll
            for (int r = 0; r < 16; ++r) wg[r] = p.w_gla[r * 512 + h * 128 + dk];
            bgv = p.b_gla[h * 128 + dk]; hw = h; }
        glr_s[tid] = P.g0; glr_s[tid + 512] = P.g1;
#pragma unroll
        for (int i = 0; i < 4; ++i) vN_store(vN, tid + NTHR * i, P.rv[i]);
        v4u rq[2], rk[2];
#pragma unroll
        for (int i = 0; i < 2; ++i) { rq[i] = P.rq[i]; rk[i] = P.rk[i]; }
        __syncthreads();
        if (cid + G < NCHUNK) locg_prefetch(P, vo, qo, p, cid + G, tid);
        __builtin_amdgcn_sched_barrier(0);
        { float run = 0.f; float loc[16];
#pragma unroll
          for (int i = 0; i < 16; ++i) { const int s = 16 * sq + i; float z = bgv;
#pragma unroll
              for (int r = 0; r < 16; ++r) z += glr_s[s * 16 + r] * wg[r];
              run += logsigmoid_fast(z) * (1.f / 16.f); loc[i] = run; }
          tot[sq * 128 + dk] = run;
          __syncthreads();
          float off = 0.f;
#pragma unroll
          for (int j = 0; j < 3; ++j) off += (j < sq) ? tot[j * 128 + dk] : 0.f;
#pragma unroll
          for (int i = 0; i < 16; ++i) cumL[(16 * sq + i) * 128 + dk] = loc[i] + off;
          __syncthreads(); }
        { bf16* QI = (bf16*)(ws + WS_QI); bf16* KI = (bf16*)(ws + WS_KI);
#pragma unroll
          for (int i = 0; i < 2; ++i) { const int s = (tid + NTHR * i) >> 4;
              float fq8[8], fk8[8], fe8[8]; unpack8(rq[i], fq8); unpack8(rk[i], fk8);
#pragma unroll
              for (int d = 0; d < 8; ++d) { const int dkk = d8 * 8 + d; const float cu = cumL[s * 128 + dkk], ce = cumL[63 * 128 + dkk];
                  fq8[d] *= RSQRT_DK * __expf(cu); fe8[d] = fk8[d] * __expf(ce - cu); fk8[d] *= __expf(-cu); }
              v4u w; w.x = pk2(fq8[0], fq8[1]); w.y = pk2(fq8[2], fq8[3]); w.z = pk2(fq8[4], fq8[5]); w.w = pk2(fq8[6], fq8[7]); *(GAS v4u*)(QI + (t0 + s) * 512 + h * 128 + d8 * 8) = w;
              w.x = pk2(fk8[0], fk8[1]); w.y = pk2(fk8[2], fk8[3]); w.z = pk2(fk8[4], fk8[5]); w.w = pk2(fk8[6], fk8[7]); *(GAS v4u*)(KI + (t0 + s) * 512 + h * 128 + d8 * 8) = w;
              w.x = pk2(fe8[0], fe8[1]); w.y = pk2(fe8[2], fe8[3]); w.z = pk2(fe8[4], fe8[5]); w.w = pk2(fe8[6], fe8[7]); *(LAS v4u*)(keN + kn_off(s, d8 * 16)) = w; } }
        if (tid < 128) ((float*)(ws + WS_MISC + MISC_GDEC))[(size_t)cid * 128 + tid] = __expf(cumL[63 * 128 + tid]);
        __syncthreads();
        state_mfma_store(vN, keN, (bf16*)(ws + WS_GSTATE) + (size_t)cid * 32768, wave, lane);
        __syncthreads();
    }
}

struct ScanSet { v4u dm[4], dg[4]; f32x4 da[4], db[4]; };
__device__ __forceinline__ void scan_load(ScanSet& S, const unsigned char* ws, int e, int c0) {
    const int bh = e >> 12, idx = e & 4095, dk = ((idx >> 4) & 15) * 8;
    const GAS v4u* ms = (const GAS v4u*)(ws + WS_MSTATE) + (size_t)bh * 64 * 4096 + idx; const GAS v4u* gs = (const GAS v4u*)(ws + WS_GSTATE) + (size_t)bh * 64 * 4096 + idx;
    const GAS float* ds = (const GAS float*)(ws + WS_MISC + MISC_GDEC) + (size_t)bh * 64 * 128 + dk;
#pragma unroll
    for (int j = 0; j < 4; ++j) { S.dm[j] = ms[(size_t)(c0 + j) * 4096]; S.dg[j] = gs[(size_t)(c0 + j) * 4096]; S.da[j] = *(const GAS f32x4*)(ds + (c0 + j) * 128); S.db[j] = *(const GAS f32x4*)(ds + (c0 + j) * 128 + 4); }
}
__device__ __forceinline__ void scan_fold(const ScanSet& S, unsigned char* ws, int e, int c0, float (&sm)[8], float (&sl)[8], const LAS float* sa, const LAS float* sc) {
    const int bh = e >> 12, idx = e & 4095;
    GAS v4u* md = (GAS v4u*)(ws + WS_MPREV) + (size_t)bh * 64 * 4096 + idx; GAS v4u* gd = (GAS v4u*)(ws + WS_GPREV) + (size_t)bh * 64 * 4096 + idx;
#pragma unroll
    for (int j = 0; j < 4; ++j) { const int cid = bh * 64 + c0 + j;
        { v4u o; o.x = pk2(sm[0], sm[1]); o.y = pk2(sm[2], sm[3]); o.z = pk2(sm[4], sm[5]); o.w = pk2(sm[6], sm[7]); md[(size_t)(c0 + j) * 4096] = o; }
        { v4u o; o.x = pk2(sl[0], sl[1]); o.y = pk2(sl[2], sl[3]); o.z = pk2(sl[4], sl[5]); o.w = pk2(sl[6], sl[7]); gd[(size_t)(c0 + j) * 4096] = o; }
        const float a = sa[cid], cc = sc[cid]; float f[8]; unpack8(S.dm[j], f);
#pragma unroll
        for (int q = 0; q < 8; ++q) sm[q] = a * sm[q] + cc * f[q];
        unpack8(S.dg[j], f);
        sl[0] = S.da[j].x * sl[0] + f[0]; sl[1] = S.da[j].y * sl[1] + f[1]; sl[2] = S.da[j].z * sl[2] + f[2]; sl[3] = S.da[j].w * sl[3] + f[3];
        sl[4] = S.db[j].x * sl[4] + f[4]; sl[5] = S.db[j].y * sl[5] + f[5]; sl[6] = S.db[j].z * sl[6] + f[6]; sl[7] = S.db[j].w * sl[7] + f[7]; }
}
__device__ __forceinline__ void scan_phase(const KP& p, LAS unsigned char* L, int G, int tid) {
    unsigned char* ws = p.ws;
    LAS float* sg = (LAS float*)L; LAS float* sbe = sg + 2048; LAS float* sa = sg + 4096; LAS float* sc = sg + 6144;
    const float* GEND = (const float*)(ws + WS_MISC + MISC_GEND); const float* BEND = (const float*)(ws + WS_MISC + MISC_BEND);
    float* MPREV = (float*)(ws + WS_MISC + MISC_MPREV); float* NPREV = (float*)(ws + WS_MISC + MISC_NPREV);
    const int NT = G * NTHR, gt = blockIdx.x * NTHR + tid; constexpr int NI = NBH * 4096;
    ScanSet A, B; int e = gt;
    if (e < NI) scan_load(A, ws, e, 0);
    for (int i = tid; i < 2048; i += NTHR) { sg[i] = GEND[i]; sbe[i] = BEND[i]; }
    __syncthreads();
    if (tid < 32) { float m = 0.f;
        for (int c = 0; c < 64; ++c) { const int id = tid * 64 + c; const float g = sg[id], be = sbe[id];
            if (blockIdx.x == 0) MPREV[id] = m;
            const float mn = fmaxf(be + m, g); sa[id] = expf(be + m - mn); sc[id] = expf(g - mn); m = mn; } }
    __syncthreads();
    for (; e < NI; e += NT) { float sm[8], sl[8];
#pragma unroll
        for (int q = 0; q < 8; ++q) { sm[q] = 0.f; sl[q] = 0.f; }
#pragma unroll 1
        for (int c0 = 0; c0 < 64; c0 += 8) {
            scan_load(B, ws, e, c0 + 4);
            scan_fold(A, ws, e, c0, sm, sl, sa, sc);
            if (c0 + 8 < 64) scan_load(A, ws, e, c0 + 8); else if (e + NT < NI) scan_load(A, ws, e + NT, 0);
            scan_fold(B, ws, e, c0 + 4, sm, sl, sa, sc); } }
    { const float* DN = (const float*)(ws + WS_MISC + MISC_DN);
      for (int e2 = gt; e2 < NBH * 128; e2 += NT) { const int bh = e2 >> 7, dk = e2 & 127; float st = 0.f;
#pragma unroll 1
          for (int c0 = 0; c0 < 64; c0 += 16) { float d[16];
#pragma unroll
              for (int j = 0; j < 16; ++j) d[j] = DN[(size_t)(bh * 64 + c0 + j) * 128 + dk];
#pragma unroll
              for (int j = 0; j < 16; ++j) { const int cid = bh * 64 + c0 + j; NPREV[cid * 128 + dk] = st; st = sa[cid] * st + sc[cid] * d[j]; } } } }
}

struct OutPre { v4u rq[2], rk[2], rv[4]; bf16x8 ct[2][4]; float f0, f1, f2; };
struct OutOff { unsigned qo, vo, co; };
template <bool gla> __device__ __forceinline__ void out_prefetch(OutPre& P, const OutOff& O, const KP& p, int cid, int tid, int lane, int wave) {
    unsigned char* ws = p.ws;
    const int bh = cid >> 6, c = cid & 63, b = bh >> 2, h = bh & 3; const size_t t0 = (size_t)b * SEQ + c * 64;
    const char* qb = (const char*)((const bf16*)(ws + (gla ? WS_QI : WS_QC)) + t0 * 512 + h * 128);
    const char* kb = (const char*)((const bf16*)(ws + (gla ? WS_KI : WS_KC)) + t0 * 512 + h * 128);
    const char* vb = (const char*)((const bf16*)(ws + WS_PROJ) + t0 * NPROJ + (gla ? PC_GV : PC_MV) + h * 256);
    const char* cb = (const char*)((const bf16*)(ws + (gla ? WS_GPREV : WS_MPREV)) + (size_t)cid * 32768 + (size_t)(2 * wave) * 16 * 16 * 8);
#pragma unroll
    for (int i = 0; i < 2; ++i) { P.rq[i] = *(const GAS v4u*)(qb + (size_t)i * 32 * 512 * 2 + O.qo); P.rk[i] = *(const GAS v4u*)(kb + (size_t)i * 32 * 512 * 2 + O.qo); }
#pragma unroll
    for (int i = 0; i < 4; ++i) P.rv[i] = *(const GAS v4u*)(vb + (size_t)i * 16 * NPROJ * 2 + O.vo);
#pragma unroll
    for (int i = 0; i < 2; ++i)
#pragma unroll
        for (int ks = 0; ks < 4; ++ks) P.ct[i][ks] = *(const GAS bf16x8*)(cb + (size_t)((i * 16 + 4 * ks) * 16 * 8) * 2 + O.co);
    P.f0 = 0.f; P.f1 = 0.f; P.f2 = 0.f;
    if (!gla) { const float* SMALL = (const float*)(ws + WS_SMALL);
        if (wave == 0) { P.f0 = SMALL[(t0 + lane) * 32 + 4 + h]; P.f1 = SMALL[(t0 + lane) * 32 + h]; P.f2 = ((const float*)(ws + WS_MISC + MISC_MPREV))[cid]; }
        else if (tid < 192) P.f0 = ((const float*)(ws + WS_MISC + MISC_NPREV))[cid * 128 + tid - 64];
    }
}
template <bool gla> __device__ __forceinline__ void mixer_out_phase(const KP& p, LAS unsigned char* L, int bx, int G, int tid, int lane, int wave) {
    unsigned char* ws = p.ws;
    const int fr = lane & 15, fq = lane >> 4, d8 = tid & 15, rt = tid >> 3, seg = tid & 7;
    constexpr int QK_PITCH = 144;
    LAS bf16* q = (LAS bf16*)(L + 0); LAS bf16* k = (LAS bf16*)(L + 18432); LAS unsigned char* vN = L + 36864; LAS bf16* Sb = (LAS bf16*)(L + 71680);
    LAS float* sb = (LAS float*)(L + 80896); LAS float* sli = sb + 64; LAS float* smt = sb + 128; LAS float* sdec = sb + 192; LAS float* sden = sb + 256; LAS float* snp = sb + 320;
    LAS float* hbuf = (LAS float*)L;
    if (bx >= NCHUNK) return;
    OutOff O; O.qo = (unsigned)(((tid >> 4) * 512 + d8 * 8) * 2); O.vo = (unsigned)(((tid >> 5) * NPROJ + (tid & 31) * 8) * 2); O.co = (unsigned)(((fq * 16 + fr) * 8) * 2);
    OutPre P; out_prefetch<gla>(P, O, p, bx, tid, lane, wave);
#pragma unroll 1
    for (int cid = bx; cid < NCHUNK; cid += G) {
        const int bh = cid >> 6, c = cid & 63, b = bh >> 2, h = bh & 3; const size_t t0 = (size_t)b * SEQ + c * 64;
        if (!gla) {
            if (wave == 0) {
                float bc = logsigmoidf(P.f0); const float ip = P.f1, mprev = P.f2;
#pragma unroll
                for (int o = 1; o < 64; o <<= 1) { const float n = __shfl_up(bc, o); if (lane >= o) bc += n; }
                float pm = ip - bc;
#pragma unroll
                for (int o = 1; o < 64; o <<= 1) { const float n = __shfl_up(pm, o); if (lane >= o) pm = fmaxf(pm, n); }
                const float mt = bc + fmaxf(mprev, pm);
                sb[lane] = bc; sli[lane] = ip; smt[lane] = mt; sdec[lane] = expf(bc + mprev - mt);
            } else if (tid < 192) snp[tid - 64] = P.f0;
        }
#pragma unroll
        for (int i = 0; i < 4; ++i) vN_store(vN, tid + NTHR * i, P.rv[i]);
#pragma unroll
        for (int i = 0; i < 2; ++i) { const int s = (tid + NTHR * i) >> 4; *(LAS v4u*)(q + s * QK_PITCH + d8 * 8) = P.rq[i]; *(LAS v4u*)(k + s * QK_PITCH + d8 * 8) = P.rk[i]; }
        bf16x8 bcx[2][4];
#pragma unroll
        for (int i = 0; i < 2; ++i)
#pragma unroll
            for (int ks = 0; ks < 4; ++ks) bcx[i][ks] = P.ct[i][ks];
        __syncthreads();
        if (cid + G < NCHUNK) out_prefetch<gla>(P, O, p, cid + G, tid, lane, wave);
        __builtin_amdgcn_sched_barrier(0);
        { const int tt = wave >> 1;
          bf16x8 a[4];
#pragma unroll
          for (int ks = 0; ks < 4; ++ks) a[ks] = *(const LAS bf16x8*)(q + (16 * tt + fr) * QK_PITCH + 32 * ks + 8 * fq);
#pragma unroll
          for (int i = 0; i < 2; ++i) { const int st = 2 * (wave & 1) + i; f32x4 acc = {0.f, 0.f, 0.f, 0.f};
#pragma unroll
              for (int ks = 0; ks < 4; ++ks) { const bf16x8 bb = *(const LAS bf16x8*)(k + (16 * st + fr) * QK_PITCH + 32 * ks + 8 * fq); acc = __builtin_amdgcn_mfma_f32_16x16x32_bf16(a[ks], bb, acc, 0, 0, 0); }
              const int s = 16 * st + fr;
#pragma unroll
              for (int r = 0; r < 4; ++r) { const int t = 16 * tt + 4 * fq + r; float wgt;
                  if (!gla) wgt = (s <= t) ? __expf(sb[t] - sb[s] + sli[s] - smt[t]) : 0.f; else wgt = (s <= t) ? 1.f : 0.f;
                  Sb[t * 72 + s] = (bf16)f2bf(acc[r] * wgt); } } }
        __syncthreads();
        if (!gla) {
            float v8[8]; unpack8(*(const LAS v4u*)(Sb + rt * 72 + 8 * seg), v8);
            float acc = ((v8[0] + v8[1]) + (v8[2] + v8[3])) + ((v8[4] + v8[5]) + (v8[6] + v8[7]));
            float qn = 0.f;
#pragma unroll
            for (int j = 0; j < 2; ++j) { float q8[8]; unpack8(*(const LAS v4u*)(q + rt * QK_PITCH + 16 * seg + 8 * j), q8);
                const f32x4 n0 = *(const LAS f32x4*)(snp + 16 * seg + 8 * j), n1 = *(const LAS f32x4*)(snp + 16 * seg + 8 * j + 4);
                qn += q8[0] * n0.x + q8[1] * n0.y + q8[2] * n0.z + q8[3] * n0.w + q8[4] * n1.x + q8[5] * n1.y + q8[6] * n1.z + q8[7] * n1.w; }
            float den = acc + sdec[rt] * qn;
            den += __shfl_xor(den, 1); den += __shfl_xor(den, 2); den += __shfl_xor(den, 4);
            if (seg == 0) sden[rt] = 1.f / fmaxf(fabsf(den), expf(-smt[rt]));
            __syncthreads();
        }
        f32x4 acc1[4][2];
        { bf16x8 bv[2][2];
#pragma unroll
          for (int i = 0; i < 2; ++i)
#pragma unroll
              for (int ks = 0; ks < 2; ++ks) bv[i][ks] = vfrag_tr(vN, 2 * wave + i, ks, fr, fq);
#pragma unroll
          for (int tt = 0; tt < 4; ++tt) { bf16x8 aq[4], as2[2]; float dec4[4];
#pragma unroll
              for (int ks = 0; ks < 4; ++ks) aq[ks] = *(const LAS bf16x8*)(q + (16 * tt + fr) * QK_PITCH + 32 * ks + 8 * fq);
#pragma unroll
              for (int ks = 0; ks < 2; ++ks) as2[ks] = *(const LAS bf16x8*)(Sb + (16 * tt + fr) * 72 + 32 * ks + 8 * fq);
#pragma unroll
              for (int r = 0; r < 4; ++r) dec4[r] = gla ? 1.f : sdec[16 * tt + 4 * fq + r];
#pragma unroll
              for (int i = 0; i < 2; ++i) { f32x4 x2 = {0.f, 0.f, 0.f, 0.f};
#pragma unroll
                  for (int ks = 0; ks < 4; ++ks) x2 = __builtin_amdgcn_mfma_f32_16x16x32_bf16(aq[ks], bcx[i][ks], x2, 0, 0, 0);
                  if (!gla) {
#pragma unroll
                      for (int r = 0; r < 4; ++r) x2[r] *= dec4[r]; }
#pragma unroll
                  for (int ks = 0; ks < 2; ++ks) x2 = __builtin_amdgcn_mfma_f32_16x16x32_bf16(as2[ks], bv[i][ks], x2, 0, 0, 0);
                  acc1[tt][i] = x2; }
              __builtin_amdgcn_sched_barrier(0); } }
        v4u gpre[4];
#pragma unroll
        for (int j = 0; j < 4; ++j) gpre[j] = *(const GAS v4u*)((const bf16*)(ws + WS_PROJ) + (t0 + rt) * NPROJ + (gla ? PC_GG : PC_MO) + h * 256 + 64 * j + 8 * seg);
        __syncthreads();
#pragma unroll
        for (int tt = 0; tt < 4; ++tt)
#pragma unroll
            for (int r = 0; r < 4; ++r) { const int t = 16 * tt + 4 * fq + r; const float dn = gla ? 1.f : sden[t];
#pragma unroll
                for (int i = 0; i < 2; ++i) hbuf[t * 260 + 16 * (2 * wave + i) + fr] = acc1[tt][i][r] * dn; }
        __syncthreads();
        { f32x4 hv[8]; float s1 = 0.f, s2 = 0.f;
#pragma unroll
          for (int j = 0; j < 8; ++j) { hv[j] = *(const LAS f32x4*)(hbuf + rt * 260 + 64 * (j >> 1) + 8 * seg + 4 * (j & 1)); s1 += (hv[j].x + hv[j].y) + (hv[j].z + hv[j].w); }
          s1 += __shfl_xor(s1, 1); s1 += __shfl_xor(s1, 2); s1 += __shfl_xor(s1, 4);
          const float mean = gla ? 0.f : s1 * (1.f / 256.f);
#pragma unroll
          for (int j = 0; j < 8; ++j) { hv[j] = hv[j] - mean; s2 += (hv[j].x * hv[j].x + hv[j].y * hv[j].y) + (hv[j].z * hv[j].z + hv[j].w * hv[j].w); }
          s2 += __shfl_xor(s2, 1); s2 += __shfl_xor(s2, 2); s2 += __shfl_xor(s2, 4);
          const float rs = 1.f / sqrtf(s2 * (1.f / 256.f) + LN_EPS);
          const float* nw = (gla ? p.g_norm_w : p.m_norm_w) + h * 256 + 8 * seg;
          if constexpr (P5_FP8) {
              unsigned char* Y8 = ws + WS_YM + (gla ? 32 * MiB : 0) + (size_t)(t0 + rt) * 1024 + h * 256 + 8 * seg;
              const float rs8 = rs * Y8_SCALE;
#pragma unroll
              for (int j = 0; j < 4; ++j) { float g8[8]; unpack8(gpre[j], g8);
                  const f32x4 w0 = *(const f32x4*)(nw + 64 * j), w1 = *(const f32x4*)(nw + 64 * j + 4);
                  const f32x4 o0 = hv[2 * j] * rs8 * w0, o1 = hv[2 * j + 1] * rs8 * w1;
                  *(GAS unsigned long long*)(Y8 + 64 * j) = (unsigned long long)pk4_fp8(o0.x * g8[0], o0.y * g8[1], o0.z * g8[2], o0.w * g8[3]) | ((unsigned long long)pk4_fp8(o1.x * g8[4], o1.y * g8[5], o1.z * g8[6], o1.w * g8[7]) << 32); }
          } else {
          bf16* Y = (bf16*)(ws + (gla ? WS_YG : WS_YM)) + (t0 + rt) * 1024 + h * 256 + 8 * seg;
#pragma unroll
          for (int j = 0; j < 4; ++j) { float g8[8]; unpack8(gpre[j], g8);
              const f32x4 w0 = *(const f32x4*)(nw + 64 * j), w1 = *(const f32x4*)(nw + 64 * j + 4);
              const f32x4 o0 = hv[2 * j] * rs * w0, o1 = hv[2 * j + 1] * rs * w1;
              v4u w; w.x = pk2(o0.x * g8[0], o0.y * g8[1]); w.y = pk2(o0.z * g8[2], o0.w * g8[3]); w.z = pk2(o1.x * g8[4], o1.y * g8[5]); w.w = pk2(o1.z * g8[6], o1.w * g8[7]);
              *(GAS v4u*)(Y + 64 * j) = w; } } }
        __syncthreads();
    }
}

__device__ __forceinline__ void ln_router_phase(const KP& p, LAS unsigned char* lds, gu32* ctl, int G, int vcu, int tid, int wave, int lane) {
    unsigned char* ws = p.ws;
    const bf16* MIX = (const bf16*)(ws + WS_PRE); bf16* X1 = (bf16*)(ws + WS_X1); unsigned char* X1F8 = ws + WS_X1F8; const bf16* WRT = (const bf16*)(ws + WS_WRT);
    int* SLOT = (int*)(ws + WS_SLOT); int* ASG_E = (int*)(ws + WS_ASG); int* ASG_R = ASG_E + T * 4; float* ASG_G = (float*)(ASG_R + T * 4);
    constexpr int XT_STRIDE = 2056;
    LAS bf16* xt = (LAS bf16*)lds; LAS float* part = (LAS float*)(lds + 65792); LAS int* ae = (LAS int*)(lds + 84224); LAS float* ag = (LAS float*)(lds + 84224 + 2048); LAS int* alr = (LAS int*)(lds + 84224 + 4096);
    LAS int* hist = (LAS int*)(lds + 90368); LAS int* basev = hist + 32;
    const int fr = lane & 15, fq = lane >> 4;
    if (tid < 32) hist[tid] = 0;
    bf16x8 bw[2][8];
#pragma unroll
    for (int ct = 0; ct < 2; ++ct)
#pragma unroll
        for (int ksl = 0; ksl < 8; ++ksl) bw[ct][ksl] = *(const GAS bf16x8*)(WRT + (size_t)(16 * ct + fr) * DM + 32 * (8 * wave + ksl) + 8 * fq);
    const float brt = p.b_router[lane & 31];
    for (int slab = vcu; slab < T / 128; slab += G) {
        const int m0 = slab * 128;
        unsigned long long px[2][8], pm[2][8];
#pragma unroll
        for (int i = 0; i < 2; ++i) { const int m = m0 + 2 * wave + i;
            const GAS unsigned long long* xr = (const GAS unsigned long long*)((const bf16*)(ws + WS_XB) + (size_t)m * DM) + lane; const GAS unsigned long long* mr = (const GAS unsigned long long*)(MIX + (size_t)m * DM) + lane;
#pragma unroll
            for (int j = 0; j < 8; ++j) { px[i][j] = xr[64 * j]; pm[i][j] = mr[64 * j]; } }
#pragma unroll 1
        for (int bt = 0; bt < 8; ++bt) {
#pragma unroll
            for (int i = 0; i < 2; ++i) { const int rl = 2 * wave + i; const int m = m0 + bt * 16 + rl;
                f32x4 v[8]; float s = 0.f;
#pragma unroll
                for (int j = 0; j < 8; ++j) { const unsigned long long xw = px[i][j]; const unsigned long long w = pm[i][j];
                    const f32x4 xv = {bf2f((unsigned)xw & 0xffffu), bf2f(((unsigned)xw) >> 16), bf2f((unsigned)(xw >> 32) & 0xffffu), bf2f((unsigned)(xw >> 48))};
                    v[j].x = DN_ALPHA * xv.x + bf2f((unsigned)w & 0xffffu); v[j].y = DN_ALPHA * xv.y + bf2f(((unsigned)w) >> 16); v[j].z = DN_ALPHA * xv.z + bf2f((unsigned)(w >> 32) & 0xffffu); v[j].w = DN_ALPHA * xv.w + bf2f((unsigned)(w >> 48));
                    s += (v[j].x + v[j].y) + (v[j].z + v[j].w); }
                const float mean = wave_sum(s) * (1.f / DM); float s2 = 0.f;
#pragma unroll
                for (int j = 0; j < 8; ++j) { v[j] = v[j] - mean; s2 += (v[j].x * v[j].x + v[j].y * v[j].y) + (v[j].z * v[j].z + v[j].w * v[j].w); }
                const float rstd = 1.f / sqrtf(wave_sum(s2) * (1.f / DM) + LN_EPS);
                GAS unsigned long long* xo = (GAS unsigned long long*)(X1 + (size_t)m * DM) + lane; GAS unsigned* x8 = (GAS unsigned*)(X1F8 + (size_t)m * DM) + lane;
                LAS unsigned long long* xl = (LAS unsigned long long*)(xt + rl * XT_STRIDE) + lane;
#pragma unroll
                for (int j = 0; j < 8; ++j) { const f32x4 g = *((const GAS f32x4*)p.ln1_g + lane + 64 * j), bb = *((const GAS f32x4*)p.ln1_b + lane + 64 * j);
                    v[j] = v[j] * rstd * g + bb;
                    const unsigned long long pk = (unsigned long long)pk2(v[j].x, v[j].y) | ((unsigned long long)pk2(v[j].z, v[j].w) << 32); xo[64 * j] = pk;
                    xl[64 * j] = (unsigned long long)pkh2(v[j].x, v[j].y) | ((unsigned long long)pkh2(v[j].z, v[j].w) << 32);
                    x8[64 * j] = pk4_fp8(v[j].x * X8_SCALE, v[j].y * X8_SCALE, v[j].z * X8_SCALE, v[j].w * X8_SCALE); } }
            if (bt + 1 < 8) {
#pragma unroll
                for (int i = 0; i < 2; ++i) { const int m = m0 + (bt + 1) * 16 + 2 * wave + i;
                    const GAS unsigned long long* xr = (const GAS unsigned long long*)((const bf16*)(ws + WS_XB) + (size_t)m * DM) + lane; const GAS unsigned long long* mr = (const GAS unsigned long long*)(MIX + (size_t)m * DM) + lane;
#pragma unroll
                    for (int j = 0; j < 8; ++j) { px[i][j] = xr[64 * j]; pm[i][j] = mr[64 * j]; } } }
            __syncthreads();
            { f32x4 a0 = {0.f, 0.f, 0.f, 0.f}, a1 = {0.f, 0.f, 0.f, 0.f};
#pragma unroll
              for (int ksl = 0; ksl < 8; ++ksl) { const bf16x8 af = *(const LAS bf16x8*)(xt + fr * XT_STRIDE + 32 * (8 * wave + ksl) + 8 * fq);
                  a0 = __builtin_amdgcn_mfma_f32_16x16x32_f16(__builtin_bit_cast(f16x8, af), __builtin_bit_cast(f16x8, bw[0][ksl]), a0, 0, 0, 0); a1 = __builtin_amdgcn_mfma_f32_16x16x32_f16(__builtin_bit_cast(f16x8, af), __builtin_bit_cast(f16x8, bw[1][ksl]), a1, 0, 0, 0); }
#pragma unroll
              for (int r = 0; r < 4; ++r) { part[wave * 512 + (4 * fq + r) * 32 + fr] = a0[r]; part[wave * 512 + (4 * fq + r) * 32 + 16 + fr] = a1[r]; } }
            __syncthreads();
            { float lgv = brt;
#pragma unroll
              for (int w = 0; w < 8; ++w) lgv += part[w * 512 + tid];
              const int myi = lane & 31; float val[4]; int sel[4]; float cur = lgv;
#pragma unroll
              for (int kk = 0; kk < 4; ++kk) { float bv = cur; int bi = myi;
#pragma unroll
                  for (int o = 1; o < 32; o <<= 1) { const float ov = __shfl_xor(bv, o); const int oi = __shfl_xor(bi, o); if (ov > bv || (ov == bv && oi < bi)) { bv = ov; bi = oi; } }
                  val[kk] = bv; sel[kk] = bi; if (myi == bi) cur = -INFINITY; }
              const float e1 = expf(val[1] - val[0]), e2 = expf(val[2] - val[0]), e3 = expf(val[3] - val[0]); const float inv = 1.f / (1.f + e1 + e2 + e3);
              if (myi < 4) { const int e = myi == 0 ? sel[0] : myi == 1 ? sel[1] : myi == 2 ? sel[2] : sel[3]; const float g = (myi == 0 ? 1.f : myi == 1 ? e1 : myi == 2 ? e2 : e3) * inv;
                  const int ai = (bt * 16 + (tid >> 5)) * 4 + myi;
                  ae[ai] = e; ag[ai] = g; alr[ai] = __hip_atomic_fetch_add(hist + e, 1, __ATOMIC_RELAXED, __HIP_MEMORY_SCOPE_WORKGROUP); } }
        }
        __syncthreads();
        if (tid < 32) { const int h = hist[tid]; basev[tid] = h > 0 ? (int)__hip_atomic_fetch_add(ctl + CW_CNT + 64 * tid, (unsigned)h, RLX_AGENT) : 0; hist[tid] = 0; }
        __syncthreads();
        { const int m = m0 + (tid >> 2), kk = tid & 3; const int e = ae[tid]; const int rank = basev[e] + alr[tid];
          SLOT[(size_t)e * T + rank] = m; ASG_E[m * 4 + kk] = e; ASG_R[m * 4 + kk] = rank; ASG_G[m * 4 + kk] = ag[tid]; }
        __syncthreads();
    }
}

__device__ __forceinline__ void final_phase(const KP& p, const LAS int* tst, int G, int vcu, int wave, int lane) {
    unsigned char* ws = p.ws;
    const bf16* X1 = (const bf16*)(ws + WS_X1); const unsigned char* OUTS = ws + WS_OUTS;
    const int* ASG_E = (const int*)(ws + WS_ASG); const int* ASG_R = ASG_E + T * 4; const float* ASG_G = (const float*)(ASG_R + T * 4);
    const int gw = vcu * NWAVES + wave, NGW = G * NWAVES;
    f32x4 lg[8], lb[8];
#pragma unroll
    for (int j = 0; j < 8; ++j) { lg[j] = *((const GAS f32x4*)p.ln2_g + lane + 64 * j); lb[j] = *((const GAS f32x4*)p.ln2_b + lane + 64 * j); }
    for (int m = gw; m < T; m += NGW) {
        f32x4 v[8]; const GAS unsigned long long* xr = (const GAS unsigned long long*)(X1 + (size_t)m * DM) + lane;
#pragma unroll
        for (int j = 0; j < 8; ++j) { const unsigned long long w = xr[64 * j];
            v[j].x = DN_ALPHA * bf2f((unsigned)w & 0xffffu); v[j].y = DN_ALPHA * bf2f(((unsigned)w) >> 16); v[j].z = DN_ALPHA * bf2f((unsigned)(w >> 32) & 0xffffu); v[j].w = DN_ALPHA * bf2f((unsigned)(w >> 48)); }
#pragma unroll
        for (int kk = 0; kk < 4; ++kk) { const int e = ASG_E[m * 4 + kk], rk = ASG_R[m * 4 + kk]; const float g = ASG_G[m * 4 + kk];
            const size_t row = (size_t)tst[e] * 256 + rk; const GAS unsigned* orow = (const GAS unsigned*)(OUTS + row * DM) + lane; const float gs = g * (1.f / O8_SCALE);
#pragma unroll
            for (int j = 0; j < 8; ++j) { const int w = (int)orow[64 * j];
                v[j].x += gs * __builtin_amdgcn_cvt_f32_fp8(w, 0); v[j].y += gs * __builtin_amdgcn_cvt_f32_fp8(w, 1); v[j].z += gs * __builtin_amdgcn_cvt_f32_fp8(w, 2); v[j].w += gs * __builtin_amdgcn_cvt_f32_fp8(w, 3); } }
        float s = 0.f;
#pragma unroll
        for (int j = 0; j < 8; ++j) s += (v[j].x + v[j].y) + (v[j].z + v[j].w);
        const float mean = wave_sum(s) * (1.f / DM); float s2 = 0.f;
#pragma unroll
        for (int j = 0; j < 8; ++j) { v[j] = v[j] - mean; s2 += (v[j].x * v[j].x + v[j].y * v[j].y) + (v[j].z * v[j].z + v[j].w * v[j].w); }
        const float rstd = 1.f / sqrtf(wave_sum(s2) * (1.f / DM) + LN_EPS);
        GAS f32x4* xo = (GAS f32x4*)(p.out + (size_t)m * DM) + lane;
#pragma unroll
        for (int j = 0; j < 8; ++j) xo[64 * j] = v[j] * rstd * lg[j] + lb[j];
    }
}

constexpr int N_PHASES = 11;
#ifndef NCONV_GROUPS
#define NCONV_GROUPS 6
#endif
#ifndef NCONV6_GROUPS
#define NCONV6_GROUPS 0
#endif
#ifndef P1_Q_HI
#define P1_Q_HI NQ_ALL
#endif
#ifndef MK_ONE_LAUNCH
#define MK_ONE_LAUNCH 1
#endif
struct Args { const float* in[22]; float* out; unsigned char* ws; int ph_lo, ph_hi, qsel; };
__global__ void __launch_bounds__(NTHR, 2) fwd(Args args) {
    extern __shared__ __attribute__((aligned(16))) unsigned char lds_raw[];
    LAS unsigned char* lds = (LAS unsigned char*)lds_raw;
    volatile LAS unsigned* MISC = (volatile LAS unsigned*)(lds + MISC_OFF);
    const int tid = threadIdx.x, lane = tid & 63, wave = __builtin_amdgcn_readfirstlane(tid >> 6);
    const int G = gridDim.x; const int bx = blockIdx.x; const int vcu = (G % 8 == 0) ? (bx % 8) * (G / 8) + bx / 8 : bx;
    KP p; p.x = args.in[0]; p.w_in = args.in[1]; p.b_in = args.in[2]; p.conv_w = args.in[3]; p.conv_b = args.in[4]; p.w_gla = args.in[5]; p.b_gla = args.in[6]; p.m_norm_w = args.in[7]; p.g_norm_w = args.in[8];
    p.w_bm = args.in[9]; p.w_bg = args.in[10]; p.w_out = args.in[11]; p.ln1_g = args.in[12]; p.ln1_b = args.in[13]; p.w_router = args.in[14]; p.b_router = args.in[15]; p.w_gu = args.in[16]; p.b_gu = args.in[17];
    p.w_down = args.in[18]; p.b_down = args.in[19]; p.ln2_g = args.in[20]; p.ln2_b = args.in[21]; p.out = args.out; p.ws = args.ws;
    unsigned char* ws = args.ws;
    gu32* ctl = (gu32*)(ws + WS_CTL);
    for (int u = tid; u < (LDS_BYTES - LDSCTL_OFF) / 4; u += NTHR) ((LAS unsigned*)(lds + LDSCTL_OFF))[u] = 0u;
    __syncthreads();
    const int lo = args.ph_lo, hi = args.ph_hi;
    XcdBarrier bar; bar.bar = (unsigned*)(ctl + CW_BAR); bar.x = 0; bar.st = nullptr;
    if (hi - lo > 1) bar = xcd_barrier_post((unsigned*)(ctl + CW_BAR), MISC + 8);
#ifndef PHASE_MASK
#define PHASE_MASK 0xffffffffu
#endif
#define IN(k) (((PHASE_MASK >> (k)) & 1u) && lo <= (k) && (k) < hi)
#define SEAM(k) do { if (IN(k) && IN((k) + 1)) xcd_barrier(bar); } while (0)
    LAS int* tst = (LAS int*)(lds + TST_OFF);

    if (IN(0)) { p0_prologue(p, lds, G, vcu, wave, lane); } SEAM(0);
    if (IN(1)) {
        const int gi = bx >> 3; const bool conv = (G == 256) && (gi < NCONV_GROUPS);
        if (!conv) {
            const int Gg = (G == 256) ? 256 - 8 * NCONV_GROUPS : G; const int cg = (G == 256) ? (gi - NCONV_GROUPS) * 8 + (bx & 7) : bx;
            { pg8::Gemm g{(const pg8::bf16_t*)(ws + WS_XB), (const pg8::bf16_t*)(ws + WS_WIN), T, NP1, DM}; SubsetOrderBf S; S.init(T, N_BF_TILES * 256, Gg, cg);
              EpiProj E{(bf16*)(ws + WS_PROJ), (float*)(ws + WS_SMALL), (const float*)(ws + WS_BIAS1), 1.f};
              pg8::gemm_phase<EpiProj, SubsetOrderBf, true, true>(lds, g, S, E); }
            if (N_F8_TILES > 0) { pg8::Gemm8 g{ws + WS_XB8, ws + WS_WIN8, DM}; SubsetOrderF8 S; S.init(T, N_F8_TILES * 256, Gg, cg);
              EpiProj E{(bf16*)(ws + WS_PROJ), (float*)(ws + WS_SMALL), (const float*)(ws + WS_BIAS1), 1.f / (X8_SCALE * W8_SCALE)};
              pg8::gemm_phase_f8<EpiProj, SubsetOrderF8>(lds, g, S, E); }
        }
        moe_convert_queue(p, lds, ctl, wave, lane, CW_QHEAD + 8 * args.qsel, 0, P1_Q_HI);
    } SEAM(1);
    if (IN(2)) { mixer_local_mlstm<0>(p, lds, bx, G, tid, lane, wave);
        int tid2 = threadIdx.x; asm volatile("" : "+v"(tid2));
        mixer_local_gla(p, lds, bx, G, tid2, tid2 & 63, wave); } SEAM(2);
    if (IN(3)) { scan_phase(p, lds, G, tid); } SEAM(3);
    if (IN(4)) { mixer_out_phase<false>(p, lds, bx, G, tid, lane, wave);
        int tid4 = threadIdx.x; asm volatile("" : "+v"(tid4));
        mixer_out_phase<true>(p, lds, bx, G, tid4, tid4 & 63, wave); } SEAM(4);
    if (IN(5)) {
        static_assert(WS_YG - WS_YM == (size_t)128 * 256 * 1024 * 2 && WS_WBG - WS_WBM == (size_t)8 * 256 * 1024 * 2, "pair offsets");
        PairOrder S; S.init(T, DM, G, bx); EpiBranchFused E{(bf16*)(ws + WS_Z), ws + WS_GATES};
        if constexpr (P5_FP8) { pg8::Gemm8 g{ws + WS_YM, ws + WS_WBM, 1024};
            pg8::gemm_phase_f8<EpiBranchFused, PairOrder>(lds, g, S, E);
        } else { pg8::Gemm g{(const pg8::bf16_t*)(ws + WS_YM), (const pg8::bf16_t*)(ws + WS_WBM), T, DM, 1024};
            pg8::gemm_phase<EpiBranchFused, PairOrder, true, true>(lds, g, S, E); }
    } SEAM(5);
    if (IN(6)) {
        const int gi = bx >> 3; const bool conv = (G == 256) && (gi < NCONV6_GROUPS);
        if (!conv) {
            const int Gg = (G == 256) ? 256 - 8 * NCONV6_GROUPS : G; const int cg = (G == 256) ? (gi - NCONV6_GROUPS) * 8 + (bx & 7) : bx;
            if constexpr (P6_FP8) { pg8::Gemm8 g{ws + WS_Z, ws + WS_WOUT8, DM}; StaticOrder8 S; S.init(T, DM, Gg, cg);
                EpiMix E{(bf16*)(ws + WS_PRE), 1.f / (Z8_SCALE * W8_SCALE)};
                pg8::gemm_phase_f8<EpiMix, StaticOrder8>(lds, g, S, E);
            } else { pg8::Gemm g{(const pg8::bf16_t*)(ws + WS_Z), (const pg8::bf16_t*)(ws + WS_WOUT), T, DM, DM}; pg8::StaticOrder S; S.init(T, DM, Gg, cg);
                EpiMix E{(bf16*)(ws + WS_PRE), 1.f};
                pg8::gemm_phase<EpiMix, pg8::StaticOrder, true, true>(lds, g, S, E); }
        }
        if (P1_Q_HI < NQ_ALL) moe_convert_queue(p, lds, ctl, wave, lane, CW_QHEAD + 32 + 8 * args.qsel, P1_Q_HI, NQ_ALL);
    } SEAM(6);
    if (IN(7)) { ln_router_phase(p, lds, ctl, G, vcu, tid, wave, lane); } SEAM(7);
    if (IN(8)) {
        moe_tables(ctl, tst, tid);
        pg8::Gemm8 g{ws + WS_X1F8, ws + WS_WGU, DM}; MoeOrder S{tst, G, bx, 16, (const int*)(ws + WS_SLOT)};
#ifdef STAGGER8
        if (G == 256 && ((bx >> 3) & 1)) { const unsigned long long t0 = __builtin_amdgcn_s_memrealtime(); while (__builtin_amdgcn_s_memrealtime() - t0 < (unsigned long long)STAGGER8) __builtin_amdgcn_s_sleep(32); }
#endif
        EpiSwiglu E{ws + WS_ACT, p.b_gu};
        pg8::gemm_phase_f8<EpiSwiglu, MoeOrder>(lds, g, S, E);
    } SEAM(8);
    if (IN(9)) {
        if (!IN(8)) moe_tables(ctl, tst, tid);
        pg8::Gemm8 g{ws + WS_ACT, ws + WS_WD, DM}; MoeOrder S{tst, G, bx, 8, nullptr};
        EpiDown E{ws + WS_OUTS, p.b_down};
        pg8::gemm_phase_f8<EpiDown, MoeOrder>(lds, g, S, E);
    } SEAM(9);
    if (IN(10)) { if (!IN(8) && !IN(9)) moe_tables(ctl, tst, tid); int lane10 = threadIdx.x & 63; asm volatile("" : "+v"(lane10));
        final_phase(p, tst, G, vcu, wave, lane10); }
#undef IN
#undef SEAM
}

#if defined(PROBE_GEMM1) || defined(PROBE_GEMM8)
struct FakeOrder { int n, c, amask, bmask;
    __device__ __forceinline__ bool next(int i, pg8::Unit& u) const { if (i >= n) return false; u.pm = (c >> 3) & amask; u.pn = c & bmask; return true; }
    __device__ __forceinline__ void a_ready(const pg8::Unit&) const {}
    __device__ __forceinline__ void done(const pg8::Unit&) const {} };
struct EpiDummy { static constexpr bool PERM = true, AFTER_DRAIN = false, CHAIN = false, HAS_PRE = false; bf16* O;
    __device__ __forceinline__ void operator()(const pg8::f32x4 (&acc)[2][2][4][2], const pg8::Unit& u, int wr, int wc, int fr, int fq) const {
        bf16* base = O + (size_t)blockIdx.x * 65536; const int row0 = wr * 64 + fr, col0 = wc * 32 + 8 * fq;
#pragma unroll
        for (int ai = 0; ai < 2; ++ai)
#pragma unroll
            for (int m = 0; m < 4; ++m)
#pragma unroll
                for (int bj = 0; bj < 2; ++bj) { const pg8::f32x4 v0 = acc[ai][bj][m][0], v1 = acc[ai][bj][m][1];
                    pg8::u32x4 w; w.x = pg8::cvt_pk_bf16(v0[0], v0[1]); w.y = pg8::cvt_pk_bf16(v0[2], v0[3]); w.z = pg8::cvt_pk_bf16(v1[0], v1[1]); w.w = pg8::cvt_pk_bf16(v1[2], v1[3]);
                    *(pg8::u32x4*)(base + (size_t)(row0 + ai * 128 + m * 16) * 256 + col0 + bj * 128) = w; } } };
#endif
#if defined(PROBE_GEMM8)
struct FakeOrder8 : FakeOrder { __device__ __forceinline__ unsigned a_row(const pg8::Unit& u, int r) const { return (unsigned)(u.pm * 256 + r); } };
#endif
#if defined(PROBE_VAR_OUT) || defined(PROBE_VAR_LOC) || defined(PROBE_GEMM1) || defined(PROBE_GEMM8) || defined(PROBE_CONV)
__global__ void __launch_bounds__(NTHR, 2) fwd_var(Args args) {
    extern __shared__ __attribute__((aligned(16))) unsigned char lds_raw[];
    LAS unsigned char* lds = (LAS unsigned char*)lds_raw;
    const int tid = threadIdx.x, lane = tid & 63, wave = __builtin_amdgcn_readfirstlane(tid >> 6);
    const int G = gridDim.x; const int bx = blockIdx.x;
    KP p; p.x = args.in[0]; p.w_in = args.in[1]; p.b_in = args.in[2]; p.conv_w = args.in[3]; p.conv_b = args.in[4]; p.w_gla = args.in[5]; p.b_gla = args.in[6]; p.m_norm_w = args.in[7]; p.g_norm_w = args.in[8];
    p.w_bm = args.in[9]; p.w_bg = args.in[10]; p.w_out = args.in[11]; p.ln1_g = args.in[12]; p.ln1_b = args.in[13]; p.w_router = args.in[14]; p.b_router = args.in[15]; p.w_gu = args.in[16]; p.b_gu = args.in[17];
    p.w_down = args.in[18]; p.b_down = args.in[19]; p.ln2_g = args.in[20]; p.ln2_b = args.in[21]; p.out = args.out; p.ws = args.ws;
#if defined(PROBE_CONV)
    { gu32* ctl = (gu32*)(args.ws + WS_CTL); if ((bx >> 3) < PROBE_CONV) moe_convert_queue(p, lds, ctl, wave, lane, CW_QHEAD + 48, 0, NQ_ALL); (void)tid; (void)G; }
#elif defined(PROBE_GEMM8)
    { unsigned char* ws = args.ws; pg8::Gemm8 g{ws + WS_ACT, ws + WS_WD, DM}; FakeOrder8 S; S.n = PROBE_GEMM8; S.c = bx; S.amask = PROBE_AMASK; S.bmask = PROBE_BMASK;
      EpiDummy E{(bf16*)(ws + WS_XS)}; pg8::gemm_phase_f8<EpiDummy, FakeOrder8>(lds, g, S, E); (void)tid; (void)lane; (void)wave; (void)p; }
#elif defined(PROBE_GEMM1)
    { unsigned char* ws = args.ws; pg8::Gemm g{(const pg8::bf16_t*)(ws + WS_XB), (const pg8::bf16_t*)(ws + WS_WIN), T, NP1, DM}; FakeOrder S{PROBE_GEMM1, bx, PROBE_AMASK, PROBE_BMASK};
      EpiDummy E{(bf16*)(ws + WS_T1)}; pg8::gemm_phase<EpiDummy, FakeOrder, true, true>(lds, g, S, E); (void)tid; (void)lane; (void)wave; (void)p; }
#elif defined(PROBE_VAR_OUT)
    mixer_out_phase<PROBE_VAR_GLA>(p, lds, bx, G, tid, lane, wave);
#else
    if (PROBE_VAR_GLA) mixer_local_gla(p, lds, bx, G, tid, lane, wave); else mixer_local_mlstm<PROBE_LOCX>(p, lds, bx, G, tid, lane, wave);
#endif
}
#endif
extern "C" void kernel_launch(void* const* d_in, const int* in_sizes, int n_in, void* d_out, int out_size, void* d_ws, size_t ws_size, hipStream_t stream) {
    static int grid = 0;
    if (grid == 0) {
        if (n_in != 22 || in_sizes[0] != T * DM || out_size != T * DM || ws_size < WS_END) { fprintf(stderr, "kernel_launch: unexpected problem (n_in %d, in0 %d, out %d, ws %zu < %zu); nothing launched\n", n_in, n_in > 0 ? in_sizes[0] : -1, out_size, ws_size, (size_t)WS_END); grid = -1; return; }
        int dev = 0, cus = 0, per_cu = 0;
        if (hipGetDevice(&dev) != hipSuccess || hipDeviceGetAttribute(&cus, hipDeviceAttributeMultiprocessorCount, dev) != hipSuccess) { grid = -1; return; }
        if (hipFuncSetAttribute((const void*)fwd, hipFuncAttributeMaxDynamicSharedMemorySize, LDS_BYTES) != hipSuccess) { fprintf(stderr, "kernel_launch: hipFuncSetAttribute failed\n"); grid = -1; return; }
        if (hipOccupancyMaxActiveBlocksPerMultiprocessor(&per_cu, (const void*)fwd, NTHR, LDS_BYTES) != hipSuccess || per_cu < 1) fprintf(stderr, "kernel_launch: occupancy query reports %d\n", per_cu);
        (void)hipGetLastError();
        grid = cus;
    }
    if (grid < 0) return;
    if (hipMemsetAsync((char*)d_ws + WS_CTL, 0, CTL_ZERO_BYTES, stream) != hipSuccess) return;
    Args a{};
    for (int i = 0; i < 22; ++i) a.in[i] = (const float*)d_in[i];
    a.out = (float*)d_out; a.ws = (unsigned char*)d_ws;
#if defined(PROBE_SEQ)
    { const int seq[] = {PROBE_SEQ}; int seen[16] = {0}; for (unsigned i = 0; i < sizeof(seq) / sizeof(int); ++i) { a.ph_lo = seq[i]; a.ph_hi = seq[i] + 1; a.qsel = seq[i] < 16 ? seen[seq[i]]++ : 0;
#if defined(PROBE_VAR_OUT) || defined(PROBE_VAR_LOC) || defined(PROBE_GEMM1) || defined(PROBE_GEMM8) || defined(PROBE_CONV)
        if (seq[i] == 100) { a.ph_lo = 0; a.ph_hi = 0; hipFuncSetAttribute((const void*)fwd_var, hipFuncAttributeMaxDynamicSharedMemorySize, LDS_BYTES); hipLaunchKernelGGL(fwd_var, dim3(grid), dim3(NTHR), LDS_BYTES, stream, a); continue; }
#endif
        hipLaunchKernelGGL(fwd, dim3(grid), dim3(NTHR), LDS_BYTES, stream, a); } }
#elif MK_ONE_LAUNCH
    a.ph_lo = 0; a.ph_hi = N_PHASES;
    hipLaunchKernelGGL(fwd, dim3(grid), dim3(NTHR), LDS_BYTES, stream, a);
#else
    for (int ph = 0; ph < N_PHASES; ++ph) { a.ph_lo = ph; a.ph_hi = ph + 1; hipLaunchKernelGGL(fwd, dim3(grid), dim3(NTHR), LDS_BYTES, stream, a); }
#endif
}
```
